# Optimizing an MI355X kernel written in HIP

```python
import math
import jax
import jax.numpy as jnp
from jax import lax
import numpy as np

D_MODEL = 1024
BATCH = 2
SEQ = 8192
DEPTH = 1
DEC_BATCH = 32
DEC_SEQ = 1
PAST_LEN = 8192
PAGE_SIZE = 128

HEAD_DIM = 64
N_ATT_HEADS = 8
N_IDX_HEADS = 8
IDX_DIM = 64
TOPK_MAX = 256
N_RET_HEADS = 4
N_MEM_HEADS = 4
N_MEM = 256
D_FF = 2816
RET_CHUNK = 128
Q_BLOCK = 128
EPS = 1e-6
ROPE_BASE = 10000.0

ATT_W = N_ATT_HEADS * HEAD_DIM
RET_W = N_RET_HEADS * HEAD_DIM
MEM_W = N_MEM_HEADS * HEAD_DIM
MIX_W = ATT_W + RET_W + MEM_W
IDXQ_W = N_IDX_HEADS * IDX_DIM
SPLITS = (ATT_W, ATT_W, ATT_W, IDXQ_W, IDX_DIM, N_IDX_HEADS, RET_W, RET_W, RET_W, RET_W, MEM_W)
IN_W = ATT_W * 3 + IDXQ_W + IDX_DIM + N_IDX_HEADS + RET_W * 4 + MEM_W

kernel_name = 'hymba_dsa_retention_macaron_step'

F32 = jnp.float32


def rms_norm(x, g):
    xf = x.astype(F32)
    y = xf * lax.rsqrt(jnp.mean(xf * xf, axis=-1, keepdims=True) + EPS)
    return (y * g.astype(F32)).astype(x.dtype)


def macaron_half(x, norm_g, w_gu, w_down):
    h = rms_norm(x, norm_g)
    gate, up = jnp.split(h @ w_gu, 2, axis=-1)
    return x + 0.5 * ((jax.nn.silu(gate) * up) @ w_down)


def rotary(x, pos):
    half = HEAD_DIM // 2
    inv = ROPE_BASE ** (-jnp.arange(half, dtype=F32) / half)
    ang = pos.astype(F32)[:, None] * inv[None, :]
    cos = jnp.cos(ang)[:, None, :]
    sin = jnp.sin(ang)[:, None, :]
    xf = x.astype(F32)
    x1, x2 = xf[..., :half], xf[..., half:]
    return jnp.concatenate([x1 * cos - x2 * sin, x1 * sin + x2 * cos], axis=-1).astype(x.dtype)


def ret_log_decay():
    return jnp.log1p(-(2.0 ** (-5.0 - jnp.arange(N_RET_HEADS, dtype=F32))))


def project_mix(h, pos, w_in, att_q_norm_g, att_k_norm_g, mem_q_norm_g):
    B, T = h.shape[0], h.shape[1]
    offs = np.cumsum(np.array(SPLITS))[:-1].tolist()
    q, k, v, qi, ki, wi, rq, rk, rv, rg, mq = jnp.split(h @ w_in, offs, axis=-1)
    q = rms_norm(q.reshape(B, T, N_ATT_HEADS, HEAD_DIM), att_q_norm_g)
    k = rms_norm(k.reshape(B, T, N_ATT_HEADS, HEAD_DIM), att_k_norm_g)
    v = v.reshape(B, T, N_ATT_HEADS, HEAD_DIM)
    qi = qi.reshape(B, T, N_IDX_HEADS, IDX_DIM)
    rq = rotary(rq.reshape(B, T, N_RET_HEADS, HEAD_DIM), pos)
    rk = rotary(rk.reshape(B, T, N_RET_HEADS, HEAD_DIM), pos) * (HEAD_DIM ** -0.5)
    rv = rv.reshape(B, T, N_RET_HEADS, HEAD_DIM)
    mq = rms_norm(mq.reshape(B, T, N_MEM_HEADS, HEAD_DIM), mem_q_norm_g)
    return q, k, v, qi, ki, wi, rq, rk, rv, rg, mq


def mix_output(att, ret, rg, mo, ret_gn_g, w_out):
    B, T = att.shape[0], att.shape[1]
    dt = att.dtype
    ret = rms_norm(ret, ret_gn_g).astype(dt).reshape(B, T, RET_W)
    cat = jnp.concatenate([att.reshape(B, T, ATT_W), jax.nn.silu(rg) * ret, mo.reshape(B, T, MEM_W)], axis=-1)
    return cat @ w_out


def indexer_scores(qi, wi, ki):
    logits = jnp.einsum('bthd,bsd->bths', qi.astype(F32), ki.astype(F32)) * (IDX_DIM ** -0.5)
    return jnp.einsum('bth,bths->bts', wi.astype(F32) * (N_IDX_HEADS ** -0.5), jax.nn.relu(logits))


def select_topk(iscore, valid, topk):
    masked = jnp.where(valid, iscore, -jnp.inf)
    top_s, top_i = lax.top_k(masked, topk)
    return top_i, jnp.isfinite(top_s)


def sparse_attend(q, k_sel, v_sel, sel_valid):
    s = jnp.einsum('bthd,btkhd->bthk', q.astype(F32), k_sel.astype(F32)) * (HEAD_DIM ** -0.5)
    s = jnp.where(sel_valid[:, :, None, :], s, -jnp.inf)
    p = jax.nn.softmax(s, axis=-1)
    return jnp.einsum('bthk,btkhd->bthd', p, v_sel.astype(F32)).astype(q.dtype)


def dsa_prompt(q, k, v, qi, ki, wi):
    B, S = q.shape[0], q.shape[1]
    topk = min(TOPK_MAX, S // 4)
    nblk = S // Q_BLOCK
    key_pos = jnp.arange(S, dtype=jnp.int32)
    bidx = jnp.arange(B, dtype=jnp.int32)[:, None, None]

    def blocks(a):
        return jnp.moveaxis(a.reshape((B, nblk, Q_BLOCK) + a.shape[2:]), 1, 0)

    def one_block(args):
        qb, qib, wib, start = args
        qpos = start + jnp.arange(Q_BLOCK, dtype=jnp.int32)
        iscore = indexer_scores(qib, wib, ki)
        valid = key_pos[None, None, :] <= qpos[None, :, None]
        top_i, sel_valid = select_topk(iscore, valid, topk)
        return sparse_attend(qb, k[bidx, top_i], v[bidx, top_i], sel_valid)

    starts = jnp.arange(nblk, dtype=jnp.int32) * Q_BLOCK
    out = lax.map(one_block, (blocks(q), blocks(qi), blocks(wi), starts))
    return jnp.moveaxis(out, 0, 1).reshape(B, S, N_ATT_HEADS, HEAD_DIM)


def dsa_sample(q, k, v, qi, ki, wi, cache_k, cache_v, cache_kidx, page_table):
    B, T = q.shape[0], q.shape[1]
    past_len = page_table.shape[1] * PAGE_SIZE
    topk = min(TOPK_MAX, (past_len + T) // 4)
    bidx = jnp.arange(B, dtype=jnp.int32)[:, None, None]
    ki_past = cache_kidx[page_table].reshape(B, past_len, IDX_DIM)
    iscore = jnp.concatenate([indexer_scores(qi, wi, ki_past), indexer_scores(qi, wi, ki)], axis=-1)
    t = jnp.arange(T, dtype=jnp.int32)
    valid = jnp.concatenate([jnp.ones((T, past_len), dtype=bool), t[None, :] <= t[:, None]], axis=-1)[None]
    top_i, sel_valid = select_topk(iscore, valid, topk)
    is_past = (top_i < past_len)[..., None, None]
    ip = jnp.minimum(top_i, past_len - 1)
    phys = page_table[bidx, ip // PAGE_SIZE]
    off = ip % PAGE_SIZE
    inew = jnp.clip(top_i - past_len, 0, T - 1)
    k_sel = jnp.where(is_past, cache_k[phys, off].astype(k.dtype), k[bidx, inew])
    v_sel = jnp.where(is_past, cache_v[phys, off].astype(v.dtype), v[bidx, inew])
    return sparse_attend(q, k_sel, v_sel, sel_valid)


def retention_chunk(S, q, k, v, log_g):
    C = q.shape[1]
    i = jnp.arange(C, dtype=F32)
    diff = i[:, None] - i[None, :]
    causal = diff >= 0
    decay = jnp.where(causal[None], jnp.exp(log_g[:, None, None] * jnp.where(causal, diff, 0.0)[None]), 0.0)
    qf, kf, vf = q.astype(F32), k.astype(F32), v.astype(F32)
    scores = jnp.einsum('bihd,bjhd->bhij', qf, kf) * decay[None]
    inner = jnp.einsum('bhij,bjhd->bihd', scores, vf)
    q_dec = jnp.exp(log_g[None, :] * (i[:, None] + 1.0))
    cross = jnp.einsum('bihk,bhkv->bihv', qf, S) * q_dec[None, :, :, None]
    k_dec = jnp.exp(log_g[None, :] * (C - 1.0 - i[:, None]))
    S_new = jnp.exp(log_g * C)[None, :, None, None] * S + jnp.einsum('bjhk,bjhv->bhkv', kf * k_dec[None, :, :, None], vf)
    return S_new, inner + cross


def retention_prompt(rq, rk, rv):
    B, S = rq.shape[0], rq.shape[1]
    nc = S // RET_CHUNK
    log_g = ret_log_decay()

    def blocks(a):
        return jnp.moveaxis(a.reshape((B, nc, RET_CHUNK) + a.shape[2:]), 1, 0)

    def step(state, args):
        qc, kc, vc = args
        return retention_chunk(state, qc, kc, vc, log_g)

    S0 = jnp.zeros((B, N_RET_HEADS, HEAD_DIM, HEAD_DIM), F32)
    S_fin, o = lax.scan(step, S0, (blocks(rq), blocks(rk), blocks(rv)))
    return jnp.moveaxis(o, 0, 1).reshape(B, S, N_RET_HEADS, HEAD_DIM), S_fin


def memory_kv(mem, norm_g, w_kv, k_norm_g):
    B, M = mem.shape[0], mem.shape[1]
    mk, mv = jnp.split(rms_norm(mem, norm_g) @ w_kv, 2, axis=-1)
    mk = rms_norm(mk.reshape(B, M, N_MEM_HEADS, HEAD_DIM), k_norm_g)
    return mk, mv.reshape(B, M, N_MEM_HEADS, HEAD_DIM)


def mem_attend(mq, mk, mv):
    s = jnp.einsum('bthd,bmhd->bhtm', mq.astype(F32), mk.astype(F32)) * (HEAD_DIM ** -0.5)
    p = jax.nn.softmax(s, axis=-1)
    return jnp.einsum('bhtm,bmhd->bthd', p, mv.astype(F32)).astype(mq.dtype)


def setup_inputs(seed: int = 0) -> dict:
    key = jax.random.key(seed)
    ks = jax.random.split(key, 40)
    n_pages = PAST_LEN // PAGE_SIZE
    n_used = DEC_BATCH * n_pages
    n_pool = n_used + max(1, n_used // 4)

    def nrm(k, shape, scale=1.0):
        return jax.random.normal(k, shape, F32) * scale

    def gain(k, shape):
        return 1.0 + 0.01 * jax.random.normal(k, shape, F32)

    page_table = jax.random.permutation(ks[0], n_pool)[:n_used].reshape(DEC_BATCH, n_pages).astype(jnp.int32)
    return {
        'x_prompt': nrm(ks[1], (BATCH, SEQ, D_MODEL)),
        'x_sample': nrm(ks[2], (DEC_BATCH, DEC_SEQ, D_MODEL)),
        'mem_prompt': nrm(ks[3], (BATCH, N_MEM, D_MODEL)),
        'cache_k': nrm(ks[4], (DEPTH, n_pool, PAGE_SIZE, N_ATT_HEADS, HEAD_DIM)),
        'cache_v': nrm(ks[5], (DEPTH, n_pool, PAGE_SIZE, N_ATT_HEADS, HEAD_DIM)),
        'cache_kidx': nrm(ks[6], (DEPTH, n_pool, PAGE_SIZE, IDX_DIM)),
        'state_ret': nrm(ks[7], (DEPTH, DEC_BATCH, N_RET_HEADS, HEAD_DIM, HEAD_DIM), 0.5),
        'cache_mem_k': nrm(ks[8], (DEPTH, DEC_BATCH, N_MEM, N_MEM_HEADS, HEAD_DIM)),
        'cache_mem_v': nrm(ks[9], (DEPTH, DEC_BATCH, N_MEM, N_MEM_HEADS, HEAD_DIM)),
        'page_table': page_table,
        'ffn1_norm_g': gain(ks[10], (DEPTH, D_MODEL)),
        'ffn1_w_gu': nrm(ks[11], (DEPTH, D_MODEL, 2 * D_FF), D_MODEL ** -0.5),
        'ffn1_w_down': nrm(ks[12], (DEPTH, D_FF, D_MODEL), D_FF ** -0.5),
        'mix_norm_g': gain(ks[13], (DEPTH, D_MODEL)),
        'w_in': nrm(ks[14], (DEPTH, D_MODEL, IN_W), D_MODEL ** -0.5),
        'att_q_norm_g': gain(ks[15], (DEPTH, HEAD_DIM)),
        'att_k_norm_g': gain(ks[16], (DEPTH, HEAD_DIM)),
        'ret_gn_g': gain(ks[17], (DEPTH, N_RET_HEADS, HEAD_DIM)),
        'mem_norm_g': gain(ks[18], (DEPTH, D_MODEL)),
        'w_mem_kv': nrm(ks[19], (DEPTH, D_MODEL, 2 * MEM_W), D_MODEL ** -0.5),
        'mem_q_norm_g': gain(ks[20], (DEPTH, HEAD_DIM)),
        'mem_k_norm_g': gain(ks[21], (DEPTH, HEAD_DIM)),
        'w_out': nrm(ks[22], (DEPTH, MIX_W, D_MODEL), MIX_W ** -0.5),
        'ffn2_norm_g': gain(ks[23], (DEPTH, D_MODEL)),
        'ffn2_w_gu': nrm(ks[24], (DEPTH, D_MODEL, 2 * D_FF), D_MODEL ** -0.5),
        'ffn2_w_down': nrm(ks[25], (DEPTH, D_FF, D_MODEL), D_FF ** -0.5),
    }


def reference(x_prompt, x_sample, mem_prompt, cache_k, cache_v, cache_kidx, state_ret, cache_mem_k, cache_mem_v,
              page_table, ffn1_norm_g, ffn1_w_gu, ffn1_w_down, mix_norm_g, w_in, att_q_norm_g, att_k_norm_g,
              ret_gn_g, mem_norm_g, w_mem_kv, mem_q_norm_g, mem_k_norm_g, w_out, ffn2_norm_g, ffn2_w_gu, ffn2_w_down):
    past_len = page_table.shape[1] * PAGE_SIZE
    pos_p = jnp.arange(x_prompt.shape[1], dtype=jnp.int32)
    pos_s = past_len + jnp.arange(x_sample.shape[1], dtype=jnp.int32)
    log_g = ret_log_decay()
    yp, ys = x_prompt, x_sample
    kp_l, vp_l, kip_l, rp_l, mkp_l, mvp_l = [], [], [], [], [], []
    ks_l, vs_l, kis_l, rs_l = [], [], [], []
    for l in range(DEPTH):
        yp = macaron_half(yp, ffn1_norm_g[l], ffn1_w_gu[l], ffn1_w_down[l])
        hp = rms_norm(yp, mix_norm_g[l])
        q, k, v, qi, ki, wi, rq, rk, rv, rg, mq = project_mix(hp, pos_p, w_in[l], att_q_norm_g[l], att_k_norm_g[l], mem_q_norm_g[l])
        mk, mv = memory_kv(mem_prompt, mem_norm_g[l], w_mem_kv[l], mem_k_norm_g[l])
        att = dsa_prompt(q, k, v, qi, ki, wi)
        ret, s_fin = retention_prompt(rq, rk, rv)
        mo = mem_attend(mq, mk, mv)
        yp = yp + mix_output(att, ret, rg, mo, ret_gn_g[l], w_out[l])
        yp = macaron_half(yp, ffn2_norm_g[l], ffn2_w_gu[l], ffn2_w_down[l])
        kp_l.append(k); vp_l.append(v); kip_l.append(ki); rp_l.append(s_fin); mkp_l.append(mk); mvp_l.append(mv)
        ys = macaron_half(ys, ffn1_norm_g[l], ffn1_w_gu[l], ffn1_w_down[l])
        hs = rms_norm(ys, mix_norm_g[l])
        q, k, v, qi, ki, wi, rq, rk, rv, rg, mq = project_mix(hs, pos_s, w_in[l], att_q_norm_g[l], att_k_norm_g[l], mem_q_norm_g[l])
        att = dsa_sample(q, k, v, qi, ki, wi, cache_k[l], cache_v[l], cache_kidx[l], page_table)
        s_new, ret = retention_chunk(state_ret[l].astype(F32), rq, rk, rv, log_g)
        mo = mem_attend(mq, cache_mem_k[l], cache_mem_v[l])
        ys = ys + mix_output(att, ret, rg, mo, ret_gn_g[l], w_out[l])
        ys = macaron_half(ys, ffn2_norm_g[l], ffn2_w_gu[l], ffn2_w_down[l])
        ks_l.append(k); vs_l.append(v); kis_l.append(ki); rs_l.append(s_new)
    return (yp, ys,
            jnp.stack(kp_l), jnp.stack(vp_l), jnp.stack(kip_l), jnp.stack(rp_l), jnp.stack(mkp_l), jnp.stack(mvp_l),
            jnp.stack(ks_l), jnp.stack(vs_l), jnp.stack(kis_l), jnp.stack(rs_l))
```

```cpp
#include <hip/hip_runtime.h>
#include <cstdio>
#include <cstdint>

#ifndef MK_N_LAUNCHES
#define MK_N_LAUNCHES 1
#endif
namespace pg8 {
#define PG8_LAS __attribute__((address_space(3)))
typedef unsigned short bf16_t;
typedef short bf16x8 __attribute__((ext_vector_type(8)));
typedef float f32x4 __attribute__((ext_vector_type(4)));
typedef unsigned u32x4 __attribute__((ext_vector_type(4)));
typedef int i32x4 __attribute__((ext_vector_type(4)));
typedef int i32x8 __attribute__((ext_vector_type(8)));
__device__ __forceinline__ i32x8 cat8(bf16x8 lo, bf16x8 hi) { return __builtin_shufflevector(__builtin_bit_cast(i32x4, lo), __builtin_bit_cast(i32x4, hi), 0, 1, 2, 3, 4, 5, 6, 7); }
constexpr int BM = 256, BK = 64, HALF = 128, HTB = HALF * BK * 2  , STAGE_BYTES = 8 * HTB, NXCD = 8, WGM = 8;

__host__ __device__ __forceinline__ int lds_byte(int r, int c) { const int st = (r >> 4) * 2 + (c >> 5), rr = r & 15, cc = c & 31, ob = rr * 64 + cc * 2; return st * 1024 + (ob ^ (((ob >> 9) & 1) << 5)); }
__host__ __device__ __forceinline__ void stage_rc(int b, int& R, int& C) { const int st = b / 1024, sb = b % 1024, swz = sb ^ (((sb >> 9) & 1) << 5); R = (st >> 1) * 16 + swz / 64; C = (st & 1) * 32 + (swz % 64) / 2; }
__host__ __device__ __forceinline__ int perm32(int rho) { const int n = rho >> 4, i = rho & 15; return 8 * (i >> 2) + 4 * n + (i & 3); }

struct Unit { int pm, pn; };
struct Gemm { const bf16_t* A; const bf16_t* Bt; int M, N, K; };

struct StaticOrder {
    int nM, nN, nwg, G, c;
    __host__ __device__ void init(int M, int N, int G_, int c_) { nM = M / BM; nN = N / BM; nwg = nM * nN; G = G_; c = c_; }
    __host__ __device__ bool next(int i, Unit& u) const { return at((long)i * G + c, u); }
    __host__ __device__ bool at(const long L, Unit& u) const {
        if (L >= nwg) return false;
        int wgid = (int)L; { const int q = nwg / NXCD, r = nwg % NXCD, xcd = wgid % NXCD, off = wgid / NXCD; wgid = (xcd < r ? xcd * (q + 1) : r * (q + 1) + (xcd - r) * q) + off; }
        const int nig = WGM * nN, gid = wgid / nig, fm = gid * WGM, gsz = (nM - fm) < WGM ? (nM - fm) : WGM;
        u.pm = fm + ((wgid % nig) % gsz); u.pn = (wgid % nig) / gsz; return true;
    }
    __device__ __forceinline__ void a_ready(const Unit&) const {}
    __device__ __forceinline__ void done(const Unit&) const {}
};

__device__ __forceinline__ unsigned cvt_pk_bf16(float lo, float hi) { unsigned r; asm volatile("v_cvt_pk_bf16_f32 %0, %1, %2" : "=v"(r) : "v"(lo), "v"(hi)); return r; }
typedef float f32x2 __attribute__((ext_vector_type(2)));
#ifndef PG8_ASM_STAGE_ALL
#define PG8_ASM_STAGE_ALL 1
#endif
template <class Epi, class Sched, bool ALIGN_EPI = false, bool SP2 = false, bool F8 = false>
__device__ __forceinline__ void gemm_phase(PG8_LAS unsigned char* lds, const Gemm g, const Sched& S, const Epi& E, const int tid_in) {
    const int tid = tid_in, wid = __builtin_amdgcn_readfirstlane(tid >> 6), lane = tid & 63, wr = wid >> 2, wc = wid & 3, fr = lane & 15, fq = lane >> 4;
    const int K = g.K, nt = K / BK;
    unsigned voffA[2], voffB[2];
#pragma unroll
    for (int i = 0; i < 2; ++i) { int R, C; stage_rc(tid * 16 + i * 8192, R, C); const int Rb = Epi::PERM ? ((R & ~31) + perm32(R & 31)) : R;
        voffA[i] = (unsigned)(R * K + C) * 2u; voffB[i] = (unsigned)(Rb * K + C) * 2u; }
    const size_t kstep = (size_t)(BK * 2);
    const size_t hstep = (size_t)HALF * K * 2;
    const size_t tstep = 2 * hstep;
    const unsigned ldsw = (unsigned)wid * 1024u;
    const int aoff = lds_byte(wr * 64 + fr, fq * 8), boff = lds_byte(wc * 32 + fr, fq * 8);
#define PG8_SA(b, h) (((b) * 2 + (h)) * HTB)
#define PG8_SB(b, h) ((4 + (b) * 2 + (h)) * HTB)
#define PG8_STAGE(bufoff, gbase, voff) do { _Pragma("unroll") for (int _i = 0; _i < 2; ++_i) { \
        if constexpr (F8 || PG8_ASM_STAGE_ALL) { unsigned _keep; asm volatile("s_mov_b32 %0, m0\n\ts_mov_b32 m0, %3\n\ts_nop 0\n\tglobal_load_lds_dwordx4 %1, %2\n\ts_mov_b32 m0, %0" : "=&s"(_keep) : "v"((voff)[_i]), "s"((const char*)(gbase)), "s"((unsigned)(size_t)(lds + (bufoff) + ldsw + _i * 8192)) : "memory"); } \
        else __builtin_amdgcn_global_load_lds((const unsigned*)((const char*)(gbase) + (voff)[_i]), (PG8_LAS unsigned*)(lds + (bufoff) + ldsw + _i * 8192), 16, 0, 0); } } while (0)
#define PG8_LDA(dst, b, h) do { _Pragma("unroll") for (int m = 0; m < 4; ++m) _Pragma("unroll") for (int k = 0; k < 2; ++k) dst[m][k] = *(const PG8_LAS bf16x8*)(lds + PG8_SA(b, h) + aoff + m * 2048 + k * 1024); } while (0)
#define PG8_LDB(dst, b, h) do { _Pragma("unroll") for (int n = 0; n < 2; ++n) _Pragma("unroll") for (int k = 0; k < 2; ++k) dst[n][k] = *(const PG8_LAS bf16x8*)(lds + PG8_SB(b, h) + boff + n * 2048 + k * 1024); } while (0)
#define PG8_MMA(ai, bj, At, Bt) do { __builtin_amdgcn_s_setprio(1); _Pragma("unroll") for (int m = 0; m < 4; ++m) _Pragma("unroll") for (int n = 0; n < 2; ++n) { \
        if constexpr (F8) acc[ai][bj][m][n] = __builtin_amdgcn_mfma_scale_f32_16x16x128_f8f6f4(cat8(Bt[n][0], Bt[n][1]), cat8(At[m][0], At[m][1]), acc[ai][bj][m][n], 0, 0, 0, 0, 0, 0); \
        else { _Pragma("unroll") for (int k = 0; k < 2; ++k) acc[ai][bj][m][n] = __builtin_amdgcn_mfma_f32_16x16x32_bf16(Bt[n][k], At[m][k], acc[ai][bj][m][n], 0, 0, 0); } } __builtin_amdgcn_s_setprio(0); } while (0)
#define PG8_WAIT_V(n) asm volatile("s_waitcnt vmcnt(" #n ")" ::: "memory")
#define PG8_WAIT_L(n) asm volatile("s_waitcnt lgkmcnt(" #n ")" ::: "memory")
#define PG8_BAR __builtin_amdgcn_s_barrier()
#define PG8_SCHED __builtin_amdgcn_sched_barrier(0)
    Unit cur, nxt; int ui = 0;
    if (!S.next(0, cur)) return;
    f32x4 acc[2][2][4][2];
#pragma unroll
    for (int a = 0; a < 2; ++a)
#pragma unroll
        for (int b = 0; b < 2; ++b)
#pragma unroll
            for (int m = 0; m < 4; ++m)
#pragma unroll
                for (int n = 0; n < 2; ++n) acc[a][b][m][n] = (f32x4){0.f, 0.f, 0.f, 0.f};
    bf16x8 At[4][2], B0[2][2], B1[2][2];
    const char* cA = (const char*)g.A + (size_t)cur.pm * tstep; const char* cB = (const char*)g.Bt + (size_t)cur.pn * tstep;
    S.a_ready(cur);
    if constexpr (SP2) {
        PG8_STAGE(PG8_SB(0, 0), cB, voffB); PG8_STAGE(PG8_SB(0, 1), cB + hstep, voffB); PG8_STAGE(PG8_SA(0, 0), cA, voffA); PG8_STAGE(PG8_SA(0, 1), cA + hstep, voffA);
        if (wr == 1) PG8_BAR;
        PG8_WAIT_V(2); PG8_BAR;
        PG8_STAGE(PG8_SB(1, 0), cB + kstep, voffB); PG8_STAGE(PG8_SA(1, 0), cA + kstep, voffA); PG8_STAGE(PG8_SB(1, 1), cB + hstep + kstep, voffB);
        PG8_WAIT_V(6); PG8_BAR;
    } else {
        PG8_STAGE(PG8_SB(0, 0), cB, voffB); PG8_STAGE(PG8_SA(0, 0), cA, voffA); PG8_STAGE(PG8_SB(0, 1), cB + hstep, voffB); PG8_STAGE(PG8_SA(0, 1), cA + hstep, voffA);
        if (wr == 1) PG8_BAR;
        PG8_WAIT_V(4); PG8_BAR;
        PG8_STAGE(PG8_SB(1, 0), cB + kstep, voffB); PG8_STAGE(PG8_SA(1, 0), cA + kstep, voffA); PG8_STAGE(PG8_SB(1, 1), cB + hstep + kstep, voffB);
        PG8_WAIT_V(6); PG8_BAR;
    }
    for (;;) {
        const bool has_next = S.next(ui + 1, nxt);
        const char* nA = has_next ? (const char*)g.A + (size_t)nxt.pm * tstep : cA; const char* nB = has_next ? (const char*)g.Bt + (size_t)nxt.pn * tstep : cB;
        for (int t = 0; t < nt; t += 2) {
            const bool last = (t == nt - 2);
            const char* a1 = cA + (size_t)(t + 1) * kstep;
            const char* a2 = last ? nA : cA + (size_t)(t + 2) * kstep; const char* b2 = last ? nB : cB + (size_t)(t + 2) * kstep;
            const char* a3 = a2 + kstep; const char* b3 = b2 + kstep;
            if (last && has_next) S.a_ready(nxt);
            if constexpr (SP2) {
            PG8_LDB(B0, 0, 0); PG8_LDB(B1, 0, 1); PG8_SCHED; PG8_LDA(At, 0, 0); PG8_STAGE(PG8_SA(1, 1), a1 + hstep, voffA);
            PG8_WAIT_V(8); PG8_WAIT_L(0); PG8_BAR; PG8_MMA(0, 0, At, B0); PG8_MMA(0, 1, At, B1); PG8_BAR; PG8_SCHED;
            PG8_LDA(At, 0, 1); PG8_STAGE(PG8_SB(0, 0), b2, voffB); PG8_STAGE(PG8_SB(0, 1), b2 + hstep, voffB); PG8_STAGE(PG8_SA(0, 0), a2, voffA);
            PG8_WAIT_V(8); PG8_WAIT_L(0); PG8_BAR; PG8_MMA(1, 0, At, B0); PG8_MMA(1, 1, At, B1); PG8_BAR; PG8_SCHED;
            PG8_LDB(B0, 1, 0); PG8_LDB(B1, 1, 1); PG8_SCHED; PG8_LDA(At, 1, 0); PG8_STAGE(PG8_SA(0, 1), a2 + hstep, voffA);
            PG8_WAIT_V(8); PG8_WAIT_L(0); PG8_BAR; PG8_MMA(0, 0, At, B0); PG8_MMA(0, 1, At, B1); PG8_BAR; PG8_SCHED;
            PG8_LDA(At, 1, 1); PG8_STAGE(PG8_SB(1, 0), b3, voffB); PG8_STAGE(PG8_SB(1, 1), b3 + hstep, voffB); PG8_STAGE(PG8_SA(1, 0), a3, voffA);
            PG8_WAIT_V(8); PG8_WAIT_L(0); PG8_BAR; PG8_MMA(1, 0, At, B0); PG8_MMA(1, 1, At, B1); PG8_BAR; PG8_SCHED;
            } else {
            PG8_LDB(B0, 0, 0); PG8_SCHED; PG8_LDA(At, 0, 0); PG8_STAGE(PG8_SA(1, 1), a1 + hstep, voffA);
            PG8_WAIT_L(8); PG8_BAR; PG8_WAIT_L(0); PG8_MMA(0, 0, At, B0); PG8_BAR; PG8_SCHED;
            PG8_LDB(B1, 0, 1); PG8_STAGE(PG8_SB(0, 0), b2, voffB);
            PG8_BAR; PG8_WAIT_L(0); PG8_MMA(0, 1, At, B1); PG8_BAR;
            PG8_LDA(At, 0, 1); PG8_STAGE(PG8_SA(0, 0), a2, voffA);
            PG8_BAR; PG8_WAIT_L(0); PG8_MMA(1, 0, At, B0); PG8_BAR; PG8_SCHED;
            PG8_STAGE(PG8_SB(0, 1), b2 + hstep, voffB);
            PG8_WAIT_V(6); PG8_BAR; PG8_MMA(1, 1, At, B1); PG8_BAR;
            PG8_LDB(B0, 1, 0); PG8_SCHED; PG8_LDA(At, 1, 0); PG8_STAGE(PG8_SA(0, 1), a2 + hstep, voffA);
            PG8_WAIT_L(8); PG8_BAR; PG8_WAIT_L(0); PG8_MMA(0, 0, At, B0); PG8_BAR; PG8_SCHED;
            PG8_LDB(B1, 1, 1); PG8_STAGE(PG8_SB(1, 0), b3, voffB);
            PG8_BAR; PG8_WAIT_L(0); PG8_MMA(0, 1, At, B1); PG8_BAR;
            PG8_LDA(At, 1, 1); PG8_STAGE(PG8_SA(1, 0), a3, voffA);
            PG8_BAR; PG8_WAIT_L(0); PG8_MMA(1, 0, At, B0); PG8_BAR; PG8_SCHED;
            PG8_STAGE(PG8_SB(1, 1), b3 + hstep, voffB);
            PG8_WAIT_V(6); PG8_BAR; PG8_MMA(1, 1, At, B1); PG8_BAR;
            }
        }
        if constexpr (ALIGN_EPI) { if (wr == 0) PG8_BAR; }
        if constexpr (!Epi::AFTER_DRAIN) { E(acc, cur, wr, wc, fr, fq); S.done(cur); }
        if (!has_next) break;
#pragma unroll
        for (int a = 0; a < 2; ++a)
#pragma unroll
            for (int b = 0; b < 2; ++b)
#pragma unroll
                for (int m = 0; m < 4; ++m)
#pragma unroll
                    for (int n = 0; n < 2; ++n) acc[a][b][m][n] = (f32x4){0.f, 0.f, 0.f, 0.f};
        cur = nxt; cA = nA; cB = nB; ++ui;
        if constexpr (ALIGN_EPI) { if (wr == 1) PG8_BAR; }
    }
    PG8_WAIT_V(0);
    if constexpr (!ALIGN_EPI) { if (wr == 0) PG8_BAR; }
    PG8_BAR;
    if constexpr (Epi::AFTER_DRAIN) { E.fused(acc, cur, wr, wc, fr, fq, lds, wid, lane); S.done(cur); }
#undef PG8_SA
#undef PG8_SB
#undef PG8_STAGE
#undef PG8_LDA
#undef PG8_LDB
#undef PG8_MMA
#undef PG8_WAIT_V
#undef PG8_WAIT_L
#undef PG8_BAR
#undef PG8_SCHED
}
}
#define LAS_B __attribute__((address_space(3)))
#define LAS LAS_B
#define XB_TMO      128
#define XB_XCNT(j)  (256  + 64 * (j))
#define XB_XSUB(j)  (1280 + 64 * (j))
#define XB_XGEN(j)  (2304 + 64 * (j))
#define XB_TOP      3328
#define XB_TOPGEN   3392
#define XCD_BAR_WORDS 3456
#define XB_SPIN_CAP (1u << 18)

__device__ __forceinline__ unsigned xb_ld(unsigned* p)              { return __hip_atomic_load(p, __ATOMIC_RELAXED, __HIP_MEMORY_SCOPE_AGENT); }
__device__ __forceinline__ unsigned xb_add(unsigned* p, unsigned v) { return __hip_atomic_fetch_add(p, v, __ATOMIC_RELAXED, __HIP_MEMORY_SCOPE_AGENT); }
__device__ __forceinline__ unsigned xb_xcc_id() { return (unsigned)__builtin_amdgcn_s_getreg((3 << 11) | 20) & 0xFu; }
#define XB_SPIN(cond, bar) do { unsigned _sp = 0; while (cond) { __builtin_amdgcn_s_sleep(1); \
    if ((++_sp & 255u) == 0u) { if (xb_ld(&(bar)[XB_TMO])) break; if (_sp > XB_SPIN_CAP) { atomicAdd(&(bar)[XB_TMO], 1u); break; } } } } while (0)

struct XcdBarrier {
    unsigned* bar; unsigned x;
    volatile LAS unsigned* st;
};

__device__ __forceinline__ XcdBarrier xcd_barrier_post(unsigned* bar, volatile LAS unsigned* st, const bool thread0) {
    XcdBarrier b; b.bar = bar; b.x = xb_xcc_id(); b.st = st;
    if (thread0) (void)xb_add(&bar[XB_XCNT(b.x)], 1u);
    return b;
}
__device__ __forceinline__ void xcd_barrier_complete(unsigned* bar, unsigned x, unsigned& nloc, unsigned& nx) {
    const unsigned G = gridDim.x * gridDim.y * gridDim.z;
    unsigned sum, cnt, mine, sp = 0u;
    for (;;) {
        sum = 0u; cnt = 0u; mine = 0u;
#pragma unroll
        for (unsigned j = 0; j < 16; ++j) { const unsigned c = xb_ld(&bar[XB_XCNT(j)]); sum += c; cnt += (c > 0u) ? 1u : 0u; mine = (j == x) ? c : mine; }
        if (sum == G) break;
        __builtin_amdgcn_s_sleep(1);
        if ((++sp & 255u) == 0u) { if (xb_ld(&bar[XB_TMO])) break; if (sp > XB_SPIN_CAP) { atomicAdd(&bar[XB_TMO], 1u); break; } }
    }
    nloc = mine > 0u ? mine : 1u; nx = cnt > 0u ? cnt : 1u;
}

__device__ __forceinline__ void xcd_barrier(const XcdBarrier& b, const bool thread0) {
    asm volatile("s_waitcnt vmcnt(0)" ::: "memory");
    __syncthreads();
    if (thread0) {
        unsigned* bar = b.bar;
        __builtin_amdgcn_s_waitcnt(0);
        unsigned nloc = b.st[0], nx = b.st[1];
        if (nloc == 0u) { xcd_barrier_complete(bar, b.x, nloc, nx); b.st[0] = nloc; b.st[1] = nx; }
        const unsigned old = xb_add(&bar[XB_XSUB(b.x)], 1u);
        const unsigned gen = old / nloc;
        if (old + 1u == (gen + 1u) * nloc) {
            __builtin_amdgcn_fence(__ATOMIC_RELEASE, "agent");
            asm volatile("s_waitcnt vmcnt(0)" ::: "memory");
            const unsigned og = xb_add(&bar[XB_TOP], 1u);
            const unsigned tg = og / nx;
            if (og + 1u == (tg + 1u) * nx) xb_add(&bar[XB_TOPGEN], 1u);
            else XB_SPIN(xb_ld(&bar[XB_TOPGEN]) == tg, bar);
            __builtin_amdgcn_fence(__ATOMIC_ACQUIRE, "agent");
            xb_add(&bar[XB_XGEN(b.x)], 1u);
            asm volatile("s_waitcnt vmcnt(0)" ::: "memory");
        } else {
            XB_SPIN(xb_ld(&bar[XB_XGEN(b.x)]) == gen, bar);
            __builtin_amdgcn_fence(__ATOMIC_ACQUIRE, "agent");
            asm volatile("s_waitcnt vmcnt(0)" ::: "memory");
        }
    }
    __syncthreads();
}
#undef LAS

#define GAS __attribute__((address_space(1)))
#define LAS __attribute__((address_space(3)))
typedef unsigned short bf16;
typedef float f32x4 __attribute__((ext_vector_type(4)));
typedef float f32x2 __attribute__((ext_vector_type(2)));
typedef float f32x16 __attribute__((ext_vector_type(16)));
typedef short bf16x8 __attribute__((ext_vector_type(8)));
typedef unsigned u32x4 __attribute__((ext_vector_type(4)));
typedef unsigned u32x2 __attribute__((ext_vector_type(2)));
typedef __bf16 bf16x2v __attribute__((ext_vector_type(2)));
using pg8::Unit;

constexpr int NWAVES = 8;
constexpr int D = 1024, SEQ = 8192, NBATCH = 2, MPR = NBATCH * SEQ, NSAMP = 32, MP = 65 * 256, MEMT = 256, MEMROWS = NBATCH * MEMT, XBROWS = MP + MEMROWS;
constexpr int FF = 2816, NGU = 2 * FF, NIN = 14 * 256, NINX = 16 * 256;
constexpr int PAST = 8192, PAGE = 128, NPAGES = PAST / PAGE, SSC_LD = 8704;
constexpr int N_PHASES = 11;
constexpr float EPS = 1e-6f, LOG2E = 1.4426950408889634f;

constexpr size_t O_YP = 0, O_YS = O_YP + (size_t)MPR * D, O_KP = O_YS + (size_t)NSAMP * D, O_VP = O_KP + (size_t)MPR * 512, O_KIP = O_VP + (size_t)MPR * 512,
                 O_RETP = O_KIP + (size_t)MPR * 64, O_MKP = O_RETP + 2 * 4 * 64 * 64, O_MVP = O_MKP + (size_t)MEMROWS * 256, O_KS = O_MVP + (size_t)MEMROWS * 256,
                 O_VS = O_KS + NSAMP * 512, O_KIS = O_VS + NSAMP * 512, O_RETS = O_KIS + NSAMP * 64, O_END = O_RETS + (size_t)NSAMP * 4 * 64 * 64;

constexpr size_t MiB = 1u << 20;
constexpr size_t WS_CTL = 0, CTL_ZERO_BYTES = 32 * 1024;
constexpr size_t WS_WGU1 = 1 * MiB;
constexpr size_t WS_WD1  = WS_WGU1 + 11 * MiB;
constexpr size_t WS_WGU2 = WS_WD1 + 6 * MiB;
constexpr size_t WS_WD2  = WS_WGU2 + 11 * MiB;
constexpr size_t WS_WIN  = WS_WD2 + 6 * MiB;
constexpr size_t WS_WOUT = WS_WIN + 8 * MiB;
constexpr size_t WS_ROPE = WS_WOUT + 2 * MiB;
constexpr size_t WS_RS   = WS_ROPE + 3 * MiB;
constexpr size_t WS_XB   = WS_RS + 2 * MiB;
constexpr size_t WS_ACT  = WS_XB + 34 * MiB;
constexpr size_t WS_X1   = WS_ACT + 90 * MiB;
constexpr size_t WS_Q    = WS_X1 + 65 * MiB;
constexpr size_t WS_K    = WS_Q + 17 * MiB;
constexpr size_t WS_V    = WS_K + 17 * MiB;
constexpr size_t WS_QI   = WS_V + 17 * MiB;
constexpr size_t WS_KI   = WS_QI + 17 * MiB;
constexpr size_t WS_WI   = WS_KI + 3 * MiB;
constexpr size_t WS_RQ   = WS_WI + 1 * MiB;
constexpr size_t WS_RK   = WS_RQ + 9 * MiB;
constexpr size_t WS_RV   = WS_RK + 9 * MiB;
constexpr size_t WS_SG   = WS_RV + 9 * MiB;
constexpr size_t WS_MQ   = WS_SG + 9 * MiB;
constexpr size_t WS_RKDT = WS_MQ + 9 * MiB;
constexpr size_t WS_RVT  = WS_RKDT + 8 * MiB;
constexpr size_t WS_MK   = WS_RVT + 8 * MiB;
constexpr size_t WS_MVT  = WS_MK + 1 * MiB;
constexpr size_t WS_KVS  = WS_MVT + 1 * MiB;
constexpr size_t WS_SB   = WS_KVS + 8 * MiB;
constexpr size_t WS_CAT  = WS_SB + 4 * MiB;
constexpr size_t WS_SSC  = WS_CAT + 33 * MiB;
constexpr size_t WS_SLIST = WS_SSC + 2 * MiB - 65536;
constexpr size_t WS_VTA  = WS_SSC + 2 * MiB;
constexpr size_t WS_MASK = WS_VTA + 16 * MiB;
constexpr size_t WS_SC   = WS_MASK + 16 * MiB;
constexpr size_t WS_END  = WS_SC + 512 * MiB;
constexpr int CW_BAR = 4096, CW_QUEUE = 64, CW_SSFLAG = 96, CW_UPFLAG1 = 128, CW_UPFLAG2 = 160;

constexpr int RING_BYTES = 131072, LDSCTL_OFF = RING_BYTES, MISC_OFF = LDSCTL_OFF + 320, LDS_BYTES = 147456;

#define LDS_WAIT() asm volatile("s_waitcnt lgkmcnt(0)" ::: "memory")
#define VM_WAIT() asm volatile("s_waitcnt vmcnt(0)" ::: "memory")

__device__ __forceinline__ unsigned cvtpk(float lo, float hi) { const f32x2 v = {lo, hi}; const bf16x2v b = __builtin_convertvector(v, bf16x2v); return __builtin_bit_cast(unsigned, b); }
__device__ __forceinline__ unsigned pkh(float lo, float hi) { typedef _Float16 h2 __attribute__((ext_vector_type(2))); const h2 v = {(_Float16)lo, (_Float16)hi}; return __builtin_bit_cast(unsigned, v); }
__device__ __forceinline__ float bf_lo(unsigned w) { return __uint_as_float(w << 16); }
__device__ __forceinline__ float bf_hi(unsigned w) { return __uint_as_float(w & 0xffff0000u); }
__device__ __forceinline__ float bf2f(bf16 h) { return __uint_as_float((unsigned)h << 16); }
__device__ __forceinline__ bf16 f2bf(float f) { return (bf16)(cvtpk(f, 0.f) & 0xffffu); }
__device__ __forceinline__ float fast_exp2(float x) { return __builtin_amdgcn_exp2f(x); }
__device__ __forceinline__ float fast_rcp(float x) { return __builtin_amdgcn_rcpf(x); }
__device__ __forceinline__ float silu_f(float x) { return x * fast_rcp(1.f + fast_exp2(-LOG2E * x)); }
__device__ __forceinline__ float rsqrt_f(float x) { return 1.0f / sqrtf(x); }
template <int CTRL> __device__ __forceinline__ float dpp(float x) { return __builtin_bit_cast(float, __builtin_amdgcn_mov_dpp(__builtin_bit_cast(int, x), CTRL, 0xf, 0xf, true)); }
constexpr int XOR1 = 0xB1, XOR2 = 0x4E, XOR7 = 0x141;
__device__ __forceinline__ float sum8(float x) { x += dpp<XOR1>(x); x += dpp<XOR2>(x); x += dpp<XOR7>(x); return x; }
__device__ __forceinline__ float max8(float x) { x = fmaxf(x, dpp<XOR1>(x)); x = fmaxf(x, dpp<XOR2>(x)); x = fmaxf(x, dpp<XOR7>(x)); return x; }
__device__ __forceinline__ float xrow16_sum(float x) {
    auto s = __builtin_amdgcn_permlane16_swap(__float_as_uint(x), __float_as_uint(x), false, false);
    x = __uint_as_float(s[0]) + __uint_as_float(s[1]);
    auto t = __builtin_amdgcn_permlane32_swap(__float_as_uint(x), __float_as_uint(x), false, false);
    return __uint_as_float(t[0]) + __uint_as_float(t[1]);
}
__device__ __forceinline__ float x32_sum(float x) { auto t = __builtin_amdgcn_permlane32_swap(__float_as_uint(x), __float_as_uint(x), false, false); return __uint_as_float(t[0]) + __uint_as_float(t[1]); }
__device__ __forceinline__ float x32_max(float x) { auto t = __builtin_amdgcn_permlane32_swap(__float_as_uint(x), __float_as_uint(x), false, false); return fmaxf(__uint_as_float(t[0]), __uint_as_float(t[1])); }
__device__ __forceinline__ float wave_sum(float v) {
#pragma unroll
    for (int o = 1; o < 64; o <<= 1) v += __shfl_xor(v, o);
    return v;
}
__device__ __forceinline__ float wave_max(float v) {
#pragma unroll
    for (int o = 1; o < 64; o <<= 1) v = fmaxf(v, __shfl_xor(v, o));
    return v;
}
__device__ __forceinline__ unsigned wave_max_u(unsigned v) {
#pragma unroll
    for (int o = 1; o < 64; o <<= 1) { const unsigned t = (unsigned)__shfl_xor((int)v, o); v = v > t ? v : t; }
    return v;
}
__device__ __forceinline__ unsigned wave_min_u(unsigned v) {
#pragma unroll
    for (int o = 1; o < 64; o <<= 1) { const unsigned t = (unsigned)__shfl_xor((int)v, o); v = v < t ? v : t; }
    return v;
}
template <int CTRL, int ROWMASK> __device__ __forceinline__ unsigned dpp0(unsigned v) { return (unsigned)__builtin_amdgcn_update_dpp(0, (int)v, CTRL, ROWMASK, 0xf, false); }
__device__ __forceinline__ unsigned wave_max_u_dpp(unsigned v) {
    unsigned t;
    t = dpp0<0x111, 0xf>(v); v = v > t ? v : t;  t = dpp0<0x112, 0xf>(v); v = v > t ? v : t;
    t = dpp0<0x114, 0xf>(v); v = v > t ? v : t;  t = dpp0<0x118, 0xf>(v); v = v > t ? v : t;
    t = dpp0<0x142, 0xa>(v); v = v > t ? v : t;  t = dpp0<0x143, 0xc>(v); v = v > t ? v : t;
    return (unsigned)__builtin_amdgcn_readlane((int)v, 63);
}
__device__ __forceinline__ unsigned wave_min_u_dpp(unsigned v) { return ~wave_max_u_dpp(~v); }
__device__ __forceinline__ unsigned wave_prefix_sum_dpp(unsigned v) {
    v += dpp0<0x111, 0xf>(v); v += dpp0<0x112, 0xf>(v); v += dpp0<0x114, 0xf>(v); v += dpp0<0x118, 0xf>(v);
    v += dpp0<0x142, 0xa>(v); v += dpp0<0x143, 0xc>(v);
    return v;
}
__device__ __forceinline__ int mbcnt64(unsigned long long m) { return (int)__builtin_amdgcn_mbcnt_hi((unsigned)(m >> 32), __builtin_amdgcn_mbcnt_lo((unsigned)m, 0u)); }
__device__ __forceinline__ f32x16 mfma32(bf16x8 a, bf16x8 b, f32x16 c) { return __builtin_amdgcn_mfma_f32_32x32x16_bf16(a, b, c, 0, 0, 0); }
__device__ __forceinline__ float dot2bf(unsigned k, unsigned q, float acc) {
    return __builtin_amdgcn_fdot2_f32_bf16(__builtin_bit_cast(bf16x2v, k), __builtin_bit_cast(bf16x2v, q), acc, false);
}
__device__ __forceinline__ bf16x8 ld8(const bf16* p) { return *(const bf16x8*)p; }
__device__ __forceinline__ int perm_pos(int j) { return (j & ~31) | (j & 16) | (((j >> 2) & 1) << 3) | (((j >> 3) & 1) << 2) | (j & 3); }
__device__ __forceinline__ float log2_gamma(int h) { return __log2f(1.0f - exp2f(-5.0f - (float)h)); }

__device__ __forceinline__ void store_tr4(bf16* rowbase  , size_t ld, f32x4 v, int fr) {
    const unsigned A = cvtpk(v[0], v[1]), B = cvtpk(v[2], v[3]);
    const unsigned Ap = (unsigned)__builtin_amdgcn_mov_dpp((int)A, XOR1, 0xf, 0xf, true), Bp = (unsigned)__builtin_amdgcn_mov_dpp((int)B, XOR1, 0xf, 0xf, true);
    const unsigned sel1 = (fr & 1) ? 0x03020706u : 0x05040100u;
    const unsigned A1 = __builtin_amdgcn_perm(Ap, A, sel1), B1 = __builtin_amdgcn_perm(Bp, B, sel1);
    const bool up = (fr & 2) != 0;
    const unsigned X = up ? A1 : B1;
    const unsigned R = (unsigned)__builtin_amdgcn_mov_dpp((int)X, XOR2, 0xf, 0xf, true);
    *(u32x2*)(rowbase + (size_t)(fr & 3) * ld) = (u32x2){up ? R : A1, up ? B1 : R};
}

constexpr float W8SCALE = 32.0f;
constexpr float A8SCALE = 4.0f;
__device__ __forceinline__ unsigned cvtpk_fp8x4(float a, float b, float c, float d) { int w = 0; w = __builtin_amdgcn_cvt_pk_fp8_f32(a, b, w, false); w = __builtin_amdgcn_cvt_pk_fp8_f32(c, d, w, true); return (unsigned)w; }
__device__ __forceinline__ float row_rstd(const float* rs, int row) {
    const f32x4* p = (const f32x4*)(rs + (size_t)row * 16);
    const f32x4 a = p[0], b = p[1], c = p[2], d = p[3];
    const float s = (((a.x + a.y) + (a.z + a.w)) + ((b.x + b.y) + (b.z + b.w))) + (((c.x + c.y) + (c.z + c.w)) + ((d.x + d.y) + (d.z + d.w)));
    return rsqrt_f(s * (1.0f / D) + EPS);
}

struct EpiSwiGLU {
    static constexpr bool PERM = true, AFTER_DRAIN = false;
    bf16* O; const float* rs; float wscale; unsigned char* O8;
    __device__ __forceinline__ void operator()(const f32x4 (&acc)[2][2][4][2], const Unit& u, int wr, int wc, int fr, int fq) const {
        const int row0 = u.pm * 256 + wr * 64 + fr, col0 = u.pn * 128 + wc * 32 + 8 * fq;
#pragma unroll
        for (int ai = 0; ai < 2; ++ai)
#pragma unroll
            for (int m = 0; m < 4; ++m) {
                const int row = row0 + ai * 128 + m * 16; const float r = row_rstd(rs, row) * wscale;
                unsigned w[4];
                if (O8) {
#pragma unroll
                    for (int n = 0; n < 2; ++n) {
                        const f32x4 g = acc[ai][0][m][n] * r, up = acc[ai][1][m][n] * (r * A8SCALE);
                        w[n] = cvtpk_fp8x4(silu_f(g[0]) * up[0], silu_f(g[1]) * up[1], silu_f(g[2]) * up[2], silu_f(g[3]) * up[3]);
                    }
                    *(u32x2*)(O8 + (size_t)row * FF + col0) = (u32x2){w[0], w[1]};
                } else {
#pragma unroll
                for (int n = 0; n < 2; ++n) {
                    const f32x4 g = acc[ai][0][m][n] * r, up = acc[ai][1][m][n] * r;
                    w[2 * n] = cvtpk(silu_f(g[0]) * up[0], silu_f(g[1]) * up[1]); w[2 * n + 1] = cvtpk(silu_f(g[2]) * up[2], silu_f(g[3]) * up[3]);
                }
                *(u32x4*)(O + (size_t)row * FF + col0) = (u32x4){w[0], w[1], w[2], w[3]};
                }
            }
    }
};

struct EpiResid {
    static constexpr bool PERM = true, AFTER_DRAIN = false;
    const bf16* inb; bf16* xb; float* rs; float* outf; unsigned char* x8; float scale;
    __device__ __forceinline__ void operator()(const f32x4 (&acc)[2][2][4][2], const Unit& u, int wr, int wc, int fr, int fq) const {
        const int row0 = u.pm * 256 + wr * 64 + fr, colb = u.pn * 256 + wc * 32 + 8 * fq;
#pragma unroll
        for (int ai = 0; ai < 2; ++ai)
#pragma unroll
            for (int m = 0; m < 4; ++m) {
                const int row = row0 + ai * 128 + m * 16;
                float ssq = 0.f;
#pragma unroll
                for (int bj = 0; bj < 2; ++bj) {
                    const int col = colb + bj * 128;
                    const u32x4 rb = *(const u32x4*)(inb + (size_t)row * D + col);
                    const f32x4 r0 = {bf_lo(rb[0]), bf_hi(rb[0]), bf_lo(rb[1]), bf_hi(rb[1])}, r1 = {bf_lo(rb[2]), bf_hi(rb[2]), bf_lo(rb[3]), bf_hi(rb[3])};
                    const f32x4 v0 = r0 + acc[ai][bj][m][0] * scale, v1 = r1 + acc[ai][bj][m][1] * scale;
                    if (outf) { *(f32x4*)(outf + (size_t)row * D + col) = v0; *(f32x4*)(outf + (size_t)row * D + col + 4) = v1; }
                    if (xb) *(u32x4*)(xb + (size_t)row * D + col) = (u32x4){cvtpk(v0[0], v0[1]), cvtpk(v0[2], v0[3]), cvtpk(v1[0], v1[1]), cvtpk(v1[2], v1[3])};
                    if (x8) *(u32x2*)(x8 + (size_t)row * D + col) = (u32x2){cvtpk_fp8x4(v0[0], v0[1], v0[2], v0[3]), cvtpk_fp8x4(v1[0], v1[1], v1[2], v1[3])};
                    ssq += ((v0[0] * v0[0] + v0[1] * v0[1]) + (v0[2] * v0[2] + v0[3] * v0[3])) + ((v1[0] * v1[0] + v1[1] * v1[1]) + (v1[2] * v1[2] + v1[3] * v1[3]));
                }
                if (rs) { ssq = xrow16_sum(ssq); if (fq == 0) rs[(size_t)row * 16 + u.pn * 4 + wc] = ssq; }
            }
    }
};

constexpr float QPRESCALE = 0.125f * LOG2E;
struct EpiMix {
    static constexpr bool PERM = true, AFTER_DRAIN = false;
    const float* rs; const float* gq; const float* gk; const float* gmq; const float* gmk; const float* rope;
    bf16 *Q, *K, *V, *QI, *KI, *RQ, *RK, *RV, *SG, *MQ, *RKDT, *RVT, *MK, *MVT; float* WI; float* out; bf16* VTA;
    __device__ __forceinline__ void operator()(const f32x4 (&acc)[2][2][4][2], const Unit& u, int wr, int wc, int fr, int fq) const {
        const int pn = u.pn, pm = u.pm;
        const int row0 = pm * 256 + wr * 64 + fr;
        const int dl = 8 * fq;
        const float* gptr = (pn < 2) ? gq : (pn < 4 ? gk : (pn == 12 ? gmq : (pn == 14 ? gmk : nullptr)));
        f32x4 gv[2][2];
#pragma unroll
        for (int bj = 0; bj < 2; ++bj)
#pragma unroll
            for (int n = 0; n < 2; ++n) gv[bj][n] = gptr ? *(const f32x4*)(gptr + 32 * bj + dl + 4 * n) * (pn < 2 ? QPRESCALE : 1.0f) : (f32x4){1.f, 1.f, 1.f, 1.f};
        const float lg = log2_gamma(wc);
#pragma unroll
        for (int ai = 0; ai < 2; ++ai)
#pragma unroll
            for (int m = 0; m < 4; ++m) {
                const int row = row0 + ai * 128 + m * 16;
                const float r = (pm < 65) ? row_rstd(rs, row) : 1.0f;
                f32x4 x[2][2];
#pragma unroll
                for (int bj = 0; bj < 2; ++bj)
#pragma unroll
                    for (int n = 0; n < 2; ++n) x[bj][n] = acc[ai][bj][m][n] * r;
                if (gptr) {
                    float ssq = 0.f;
#pragma unroll
                    for (int bj = 0; bj < 2; ++bj)
#pragma unroll
                        for (int n = 0; n < 2; ++n) ssq += (x[bj][n][0] * x[bj][n][0] + x[bj][n][1] * x[bj][n][1]) + (x[bj][n][2] * x[bj][n][2] + x[bj][n][3] * x[bj][n][3]);
                    ssq = xrow16_sum(ssq);
                    const float rn = rsqrt_f(ssq * (1.0f / 64.0f) + EPS);
#pragma unroll
                    for (int bj = 0; bj < 2; ++bj)
#pragma unroll
                        for (int n = 0; n < 2; ++n) x[bj][n] = x[bj][n] * rn * gv[bj][n];
                }
                if (pn == 8 || pn == 9) {
                    const int pos = row < MPR ? (row & (SEQ - 1)) : PAST;
                    const f32x4* rp = (const f32x4*)(rope + ((size_t)pos * 32 + dl) * 2);
                    const float sc = (pn == 9) ? 0.125f : 1.0f;
#pragma unroll
                    for (int n = 0; n < 2; ++n) {
                        const f32x4 cs0 = rp[2 * n], cs1 = rp[2 * n + 1];
                        const f32x4 a = x[0][n], b = x[1][n];
                        x[0][n] = (f32x4){(a[0] * cs0[0] - b[0] * cs0[1]) * sc, (a[1] * cs0[2] - b[1] * cs0[3]) * sc, (a[2] * cs1[0] - b[2] * cs1[1]) * sc, (a[3] * cs1[2] - b[3] * cs1[3]) * sc};
                        x[1][n] = (f32x4){(a[0] * cs0[1] + b[0] * cs0[0]) * sc, (a[1] * cs0[3] + b[1] * cs0[2]) * sc, (a[2] * cs1[1] + b[2] * cs1[0]) * sc, (a[3] * cs1[3] + b[3] * cs1[2]) * sc};
                    }
                }
                if (pn == 11) {
#pragma unroll
                    for (int bj = 0; bj < 2; ++bj)
#pragma unroll
                        for (int n = 0; n < 2; ++n) x[bj][n] = (f32x4){silu_f(x[bj][n][0]), silu_f(x[bj][n][1]), silu_f(x[bj][n][2]), silu_f(x[bj][n][3])};
                }
                if (pm >= 65) {
                    const int b = pm - 65, j = row - pm * 256;
                    float* of = out + (pn == 14 ? O_MKP : O_MVP) + ((size_t)(b * 256 + j) * 4 + wc) * 64;
#pragma unroll
                    for (int bj = 0; bj < 2; ++bj) { *(f32x4*)(of + 32 * bj + dl) = x[bj][0]; *(f32x4*)(of + 32 * bj + dl + 4) = x[bj][1]; }
                    if (pn == 14) {
                        bf16* ob = MK + ((size_t)(b * 4 + wc) * 256 + j) * 64;
#pragma unroll
                        for (int bj = 0; bj < 2; ++bj) *(u32x4*)(ob + 32 * bj + dl) = (u32x4){cvtpk(x[bj][0][0], x[bj][0][1]), cvtpk(x[bj][0][2], x[bj][0][3]), cvtpk(x[bj][1][0], x[bj][1][1]), cvtpk(x[bj][1][2], x[bj][1][3])};
                    } else {
                        const int pp = perm_pos(j);
#pragma unroll
                        for (int bj = 0; bj < 2; ++bj)
#pragma unroll
                            for (int n = 0; n < 2; ++n)
#pragma unroll
                                for (int i = 0; i < 4; ++i) MVT[((size_t)(b * 4 + wc) * 64 + 32 * bj + dl + 4 * n + i) * 256 + pp] = f2bf(x[bj][n][i]);
                    }
                    continue;
                }
                if (pn == 13) {
                    if (wc == 0) {
                        bf16* ob = KI + (size_t)row * 64;
#pragma unroll
                        for (int bj = 0; bj < 2; ++bj) *(u32x4*)(ob + 32 * bj + dl) = (u32x4){cvtpk(x[bj][0][0], x[bj][0][1]), cvtpk(x[bj][0][2], x[bj][0][3]), cvtpk(x[bj][1][0], x[bj][1][1]), cvtpk(x[bj][1][2], x[bj][1][3])};
                        float* of = row < MPR ? out + O_KIP + (size_t)row * 64 : (row < MPR + NSAMP ? out + O_KIS + (size_t)(row - MPR) * 64 : nullptr);
                        if (of) {
#pragma unroll
                            for (int bj = 0; bj < 2; ++bj) { *(f32x4*)(of + 32 * bj + dl) = x[bj][0]; *(f32x4*)(of + 32 * bj + dl + 4) = x[bj][1]; }
                        }
                    } else if (wc == 1 && fq == 0) {
                        const float s = 0.04419417382415922f;
                        *(f32x4*)(WI + (size_t)row * 8) = x[0][0] * s; *(f32x4*)(WI + (size_t)row * 8 + 4) = x[0][1] * s;
                    }
                    continue;
                }
                bf16* ob;
                if (pn < 2) ob = Q + (size_t)row * 512 + pn * 256;
                else if (pn < 4) ob = K + (size_t)row * 512 + (pn - 2) * 256;
                else if (pn < 6) ob = V + (size_t)row * 512 + (pn - 4) * 256;
                else if (pn < 8) ob = QI + (size_t)row * 512 + (pn - 6) * 256;
                else if (pn == 8) ob = RQ + (size_t)row * 256;
                else if (pn == 9) ob = RK + (size_t)row * 256;
                else if (pn == 10) ob = RV + (size_t)row * 256;
                else if (pn == 11) ob = SG + (size_t)row * 256;
                else ob = MQ + (size_t)row * 256;
                ob += 64 * wc;
                if (!((pn == 4 || pn == 5) || (pn == 10 && row < MPR))) {
#pragma unroll
                    for (int bj = 0; bj < 2; ++bj) *(u32x4*)(ob + 32 * bj + dl) = (u32x4){cvtpk(x[bj][0][0], x[bj][0][1]), cvtpk(x[bj][0][2], x[bj][0][3]), cvtpk(x[bj][1][0], x[bj][1][1]), cvtpk(x[bj][1][2], x[bj][1][3])};
                }
                if (pn >= 2 && pn < 6) {
                    const size_t ocol = (size_t)((pn & 1) * 256 + 64 * wc);
                    float* of = row < MPR ? out + (pn < 4 ? O_KP : O_VP) + (size_t)row * 512 + ocol : (row < MPR + NSAMP ? out + (pn < 4 ? O_KS : O_VS) + (size_t)(row - MPR) * 512 + ocol : nullptr);
                    if (of) {
#pragma unroll
                        for (int bj = 0; bj < 2; ++bj) { *(f32x4*)(of + 32 * bj + dl) = x[bj][0]; *(f32x4*)(of + 32 * bj + dl + 4) = x[bj][1]; }
                    }
                }
                if ((pn == 4 || pn == 5) && row < MPR) {
                    const int b = row >> 13, t = row & (SEQ - 1);
                    bf16* ot = VTA + ((size_t)(b * 8 + 4 * (pn - 4) + wc) * 64) * SEQ + perm_pos(t & ~3);
#pragma unroll
                    for (int bj = 0; bj < 2; ++bj)
#pragma unroll
                        for (int n = 0; n < 2; ++n) store_tr4(ot + (size_t)(32 * bj + dl + 4 * n) * SEQ, SEQ, x[bj][n], fr);
                }
                if ((pn == 9 || pn == 10) && row < MPR) {
                    const int b = row >> 13, t = row & (SEQ - 1), j = t & 127;
                    const size_t pos = (size_t)(t & ~127) + perm_pos(j & ~3);
                    const float dec = (pn == 9) ? fast_exp2((float)(127 - j) * lg) : 1.0f;
                    bf16* ot = (pn == 9 ? RKDT : RVT) + ((size_t)(b * 4 + wc) * 64) * SEQ + pos;
#pragma unroll
                    for (int bj = 0; bj < 2; ++bj)
#pragma unroll
                        for (int n = 0; n < 2; ++n) store_tr4(ot + (size_t)(32 * bj + dl + 4 * n) * SEQ, SEQ, x[bj][n] * dec, fr);
                }
            }
    }
};

__device__ __forceinline__ void publish_unit(unsigned* flag, LAS unsigned* lcnt) {
    asm volatile("s_waitcnt vmcnt(0)" ::: "memory");
    const bool lane0 = __builtin_amdgcn_mbcnt_hi(~0u, __builtin_amdgcn_mbcnt_lo(~0u, 0u)) == 0u;
    unsigned old = 0u;
    if (lane0) old = __hip_atomic_fetch_add(lcnt, 1u, __ATOMIC_RELAXED, __HIP_MEMORY_SCOPE_WORKGROUP);
    old = (unsigned)__builtin_amdgcn_readfirstlane((int)old);
    if (old == (unsigned)(NWAVES - 1)) {
        __builtin_amdgcn_fence(__ATOMIC_RELEASE, "agent");
        asm volatile("s_waitcnt vmcnt(0)" ::: "memory");
        if (lane0) { __hip_atomic_store(lcnt, 0u, __ATOMIC_RELAXED, __HIP_MEMORY_SCOPE_WORKGROUP); (void)xb_add(flag, (unsigned)NWAVES); }
    }
}
constexpr int MIX_UNITS = 14 + 64 * 14 + 4, MIX_FLAG_TARGET = 14 * NWAVES;
struct MixOrder {
    pg8::StaticOrder S; int G, c; unsigned* flag; LAS unsigned* lcnt;
    __device__ void init(int G_, int c_, unsigned* flag_, LAS unsigned* lcnt_) { S.init(MPR, NIN, G_, c_); G = G_; c = c_; flag = flag_; lcnt = lcnt_; }
    __device__ bool next(int i, Unit& u) const {
        const int L = i * G + c, head = G > 14 ? G - 14 : 0;
        if (L >= head && L < head + 14) { u.pm = 64; u.pn = L - head; return true; }
        const int P = L < head ? L : L - 14;
        if (P < S.nwg) return S.at(P, u);
        const int e = P - S.nwg; if (e >= 4) return false;
        u.pm = 65 + (e >> 1); u.pn = 14 + (e & 1); return true;
    }
    __device__ __forceinline__ void a_ready(const Unit&) const {}
    __device__ __forceinline__ void done(const Unit& u) const {
        if (u.pm == 64) publish_unit(flag, lcnt);
    }
};

constexpr int UP_UNITS = 65 * (NGU / 256), UP_FLAG_TARGET = (NGU / 256) * NWAVES;
struct UpOrder {
    pg8::StaticOrder S; int G, c; unsigned* flag; LAS unsigned* lcnt;
    __device__ void init(int G_, int c_, unsigned* flag_, LAS unsigned* lcnt_) { S.init(MPR, NGU, G_, c_); G = G_; c = c_; flag = flag_; lcnt = lcnt_; }
    __device__ bool next(int i, Unit& u) const {
        const int L = i * G + c, NS = NGU / 256, head = G > NS ? G - NS : 0;
        if (L >= head && L < head + NS) { u.pm = 64; u.pn = L - head; return true; }
        return S.at(L < head ? L : L - NS, u);
    }
    __device__ __forceinline__ void a_ready(const Unit&) const {}
    __device__ __forceinline__ void done(const Unit& u) const {
        if (u.pm == 64) publish_unit(flag, lcnt);
    }
};
__device__ __forceinline__ bool skinny_early(int G) { const int rem = UP_UNITS % G; return MK_N_LAUNCHES == 1 && rem != 0 && G - rem >= 16; }

__device__ __forceinline__ int opaque_s(int x) { asm volatile("" : "+s"(x)); return x; }
__device__ __forceinline__ int hw_lane() { int l; asm volatile("v_mbcnt_lo_u32_b32 %0, -1, 0\n\tv_mbcnt_hi_u32_b32 %0, -1, %0" : "=v"(l)); return l; }
struct Frame {
    LAS unsigned char* lds;
    unsigned* ctl;
    int tid, lane, wave, G, gw, ngw;
    const void* const* in;
    float* out; unsigned char* ws;
};
#define WSP(T, off) ((T*)(F.ws + (off)))
#define FP(k) ((const float*)F.in[k])
#define FPI(k) ((const int*)F.in[k])

template <int K, bool F8 = false>
__device__ __forceinline__ void skinny_resid(Frame& F, const bf16* A_s, const bf16* Bt, int grp, const bf16* in_s  , float* out_s  , bf16* xb_s, float* rs_s, float scale, LAS float* part, unsigned char* x8_s = nullptr) {
    const int lane = F.lane, w = F.wave, c = lane & 31, hi = lane >> 5;
    constexpr int nks = K / 128;
    constexpr int NBATCH = nks > 11 ? 2 : 1, BS = nks / NBATCH;
    static_assert(nks % NBATCH == 0, "k-steps per wave split evenly into batches");
    const bf16* ap = A_s + (size_t)c * K + 16 * (w * nks) + 8 * hi;
    const bf16* bp = Bt + (size_t)(64 * grp + c) * K + 16 * (w * nks) + 8 * hi;
    u32x2 rbp[2][4];
#pragma unroll
    for (int tn = 0; tn < 2; ++tn)
#pragma unroll
        for (int g = 0; g < 4; ++g) rbp[tn][g] = w == 0 ? *(const u32x2*)(in_s + (size_t)c * D + 64 * grp + 32 * tn + 8 * g + 4 * hi) : (u32x2){0u, 0u};
    f32x16 acc[2];
#pragma unroll
    for (int tn = 0; tn < 2; ++tn)
#pragma unroll
        for (int i = 0; i < 16; ++i) acc[tn][i] = 0.f;
#pragma unroll
    for (int bi = 0; bi < NBATCH; ++bi) {
        if constexpr (F8) {
            const unsigned char* ap8 = (const unsigned char*)A_s + (size_t)c * K + 16 * (w * nks) + 8 * hi;
            const unsigned char* bp8 = (const unsigned char*)Bt + (size_t)(64 * grp + c) * K + 16 * (w * nks) + 8 * hi;
            long ta[BS], t0[BS], t1[BS];
#pragma unroll
            for (int i = 0; i < BS; ++i) { const int kk = bi * BS + i; ta[i] = *(const long*)(ap8 + 16 * kk); t0[i] = *(const long*)(bp8 + 16 * kk); t1[i] = *(const long*)(bp8 + (size_t)32 * K + 16 * kk); }
#pragma unroll
            for (int i = 0; i < BS; ++i) { acc[0] = __builtin_amdgcn_mfma_f32_32x32x16_fp8_fp8(t0[i], ta[i], acc[0], 0, 0, 0); acc[1] = __builtin_amdgcn_mfma_f32_32x32x16_fp8_fp8(t1[i], ta[i], acc[1], 0, 0, 0); }
        } else {
        bf16x8 ta[BS], t0[BS], t1[BS];
#pragma unroll
        for (int i = 0; i < BS; ++i) { const int kk = bi * BS + i; ta[i] = ld8(ap + 16 * kk); t0[i] = ld8(bp + 16 * kk); t1[i] = ld8(bp + (size_t)32 * K + 16 * kk); }
#pragma unroll
        for (int i = 0; i < BS; ++i) { acc[0] = mfma32(t0[i], ta[i], acc[0]); acc[1] = mfma32(t1[i], ta[i], acc[1]); }
        }
    }
#pragma unroll
    for (int tn = 0; tn < 2; ++tn)
#pragma unroll
        for (int r = 0; r < 16; ++r) part[((w * 2 + tn) * 16 + r) * 64 + lane] = acc[tn][r];
    __syncthreads();
    if (w == 0) {
        float ssq = 0.f;
        const size_t rowoff = (size_t)c * D;
#pragma unroll
        for (int tn = 0; tn < 2; ++tn)
#pragma unroll
            for (int g = 0; g < 4; ++g) {
                f32x4 v;
#pragma unroll
                for (int k = 0; k < 4; ++k) { float t = 0.f;
#pragma unroll
                    for (int ww = 0; ww < 8; ++ww) t += part[((ww * 2 + tn) * 16 + 4 * g + k) * 64 + lane];
                    v[k] = t; }
                const int col = 64 * grp + 32 * tn + 8 * g + 4 * hi;
                const u32x2 rb = rbp[tn][g];
                const f32x4 o = (f32x4){bf_lo(rb[0]), bf_hi(rb[0]), bf_lo(rb[1]), bf_hi(rb[1])} + v * scale;
                if (out_s) *(f32x4*)(out_s + rowoff + col) = o;
                if (xb_s) *(u32x2*)(xb_s + rowoff + col) = (u32x2){cvtpk(o[0], o[1]), cvtpk(o[2], o[3])};
                if (x8_s) *(unsigned*)(x8_s + rowoff + col) = cvtpk_fp8x4(o[0], o[1], o[2], o[3]);
                ssq += (o[0] * o[0] + o[1] * o[1]) + (o[2] * o[2] + o[3] * o[3]);
            }
        if (rs_s) { ssq = x32_sum(ssq); if (hi == 0) rs_s[(size_t)c * 16 + grp] = ssq; }
    }
    __syncthreads();
}

#ifdef DBG_NO_F8
#define F8W(w) 0
#else
#define F8W(w) (w)
#endif
#ifdef DBG_NO_F8D
#define F8D(w) 0
#else
#define F8D(w) (w)
#endif
struct TrDesc { const float* W; const float* gain; bf16* WTn0; int ldw, src0, nvalid, K, k0; int f8; };
__device__ __forceinline__ void tr_load(const TrDesc& d, float (&v)[32], int lane) {
#pragma unroll
    for (int i = 0; i < 32; ++i) {
        const int kk = 2 * i + (lane >> 5), j = lane & 31;
        float x = 0.f;
        if (j < d.nvalid) { x = d.W[(size_t)(d.k0 + kk) * d.ldw + d.src0 + j]; if (d.gain) x *= d.gain[d.k0 + kk]; }
        v[i] = x;
    }
}
__device__ __forceinline__ void tr_store(const TrDesc& d, const float (&v)[32], LAS float* scr, int lane) {
#pragma unroll
    for (int i = 0; i < 32; ++i) scr[(2 * i + (lane >> 5)) * 33 + (lane & 31)] = v[i];
    LDS_WAIT(); asm volatile("" ::: "memory");
    const int c = lane & 7;
#pragma unroll
    for (int jj = 0; jj < 4; ++jj) {
        const int n = (lane >> 3) + 8 * jj; const LAS float* s = scr + (8 * c) * 33 + n;
        if (d.f8) {
            *(u32x2*)((unsigned char*)d.WTn0 + (size_t)n * d.K + d.k0 + 8 * c) = (u32x2){cvtpk_fp8x4(s[0 * 33] * W8SCALE, s[1 * 33] * W8SCALE, s[2 * 33] * W8SCALE, s[3 * 33] * W8SCALE), cvtpk_fp8x4(s[4 * 33] * W8SCALE, s[5 * 33] * W8SCALE, s[6 * 33] * W8SCALE, s[7 * 33] * W8SCALE)};
        } else {
        u32x4 o; o.x = cvtpk(s[0 * 33], s[1 * 33]); o.y = cvtpk(s[2 * 33], s[3 * 33]); o.z = cvtpk(s[4 * 33], s[5 * 33]); o.w = cvtpk(s[6 * 33], s[7 * 33]);
        *(u32x4*)(d.WTn0 + (size_t)n * d.K + d.k0 + 8 * c) = o;
        }
    }
    LDS_WAIT(); asm volatile("" ::: "memory");
}
__device__ __forceinline__ void sincos_d(double a, float& c, float& s) {
    const double TWO_PI_HI = 6.283185307179586232, TWO_PI_LO = 2.449293598294706e-16, INV_2PI = 0.15915494309189534561;
    const double n = rint(a * INV_2PI);
    double r = fma(-n, TWO_PI_HI, a); r = fma(-n, TWO_PI_LO, r);
    const double r2 = r * r;
    double sn = 1.0, cs = 1.0, ts = 1.0, tc = 1.0;
#pragma unroll
    for (int k = 1; k <= 13; ++k) { tc *= -r2 * (1.0 / (double)((2 * k - 1) * (2 * k))); cs += tc; ts *= -r2 * (1.0 / (double)((2 * k) * (2 * k + 1))); sn += ts; }
    c = (float)cs; s = (float)(sn * r);
}
constexpr int TR_I_GU = 16 * (NGU / 32), TR_I_D = (FF / 64) * (D / 32), TR_I_IN = 16 * (NINX / 32), TR_I_OUT = 16 * (D / 32);
constexpr int TR_EARLY = TR_I_GU, TR_NITEMS = 2 * TR_I_GU + 2 * TR_I_D + TR_I_IN + TR_I_OUT;
__device__ __forceinline__ TrDesc tr_decode(Frame& F, int it) {
    constexpr int I_GU = TR_I_GU, I_D = TR_I_D, I_IN = TR_I_IN;
    int r = it;
    if (r < 2 * I_GU) {
        const int which = r / I_GU; r -= which * I_GU;
        const int nb = r % (NGU / 32), kb = r / (NGU / 32), n0 = nb * 32, p = n0 >> 8, rr = n0 & 255;
        const int src0 = rr < 128 ? 128 * p + rr : FF + 128 * p + (rr - 128);
        return TrDesc{which ? FP(24) : FP(11), which ? FP(23) : FP(10), F8W(which) ? (bf16*)(WSP(unsigned char, WS_WGU2) + (size_t)n0 * D) : WSP(bf16, which ? WS_WGU2 : WS_WGU1) + (size_t)n0 * D, NGU, src0, 32, D, kb * 64, F8W(which)};
    }
    r -= 2 * I_GU;
    if (r < 2 * I_D) {
        const int which = r / I_D; r -= which * I_D;
        const int nb = r % (D / 32), kb = r / (D / 32), n0 = nb * 32;
        return TrDesc{which ? FP(25) : FP(12), nullptr, F8D(which) ? (bf16*)(WSP(unsigned char, WS_WD2) + (size_t)n0 * FF) : WSP(bf16, which ? WS_WD2 : WS_WD1) + (size_t)n0 * FF, D, n0, 32, FF, kb * 64, F8D(which)};
    }
    r -= 2 * I_D;
    if (r < I_IN) {
        const int nb = r % (NINX / 32), kb = r / (NINX / 32), n0 = nb * 32, tile = n0 >> 8, tc = n0 & 255, bj = tc >> 7, wc = (tc & 127) >> 5;
        int src0 = 0, nvalid = 32; const float* W = FP(14); int ldw = 3400; const float* gain = FP(13);
        if (tile < 8) src0 = 256 * tile + 64 * wc + 32 * bj;
        else if (tile < 13) src0 = 2120 + 256 * (tile - 8) + 64 * wc + 32 * bj;
        else if (tile == 13) { if (wc == 0) src0 = 2048 + 32 * bj; else if (wc == 1 && bj == 0) { src0 = 2112; nvalid = 8; } else nvalid = 0; }
        else { W = FP(19); ldw = 512; gain = FP(18); src0 = (tile - 14) * 256 + 64 * wc + 32 * bj; }
        return TrDesc{W, gain, WSP(bf16, WS_WIN) + (size_t)n0 * D, ldw, src0, nvalid, D, kb * 64, 0};
    }
    r -= I_IN;
    { const int nb = r % (D / 32), kb = r / (D / 32), n0 = nb * 32;
      return TrDesc{FP(22), nullptr, WSP(bf16, WS_WOUT) + (size_t)n0 * D, D, n0, 32, D, kb * 64, 0}; }
}
__device__ __forceinline__ void weight_transposes(Frame& F, int it0, int it1, int w, int nw) {
    LAS float* scr = (LAS float*)(F.lds + F.wave * 16384);
    const int lane = F.lane;
    int it = it0 + w; if (it >= it1) return;
    float va[32], vb[32];
    TrDesc da = tr_decode(F, it), db = da;
    tr_load(da, va, lane);
    for (;;) {
        const int itb = it + nw; const bool hb = itb < it1;
        if (hb) { db = tr_decode(F, itb); tr_load(db, vb, lane); }
        tr_store(da, va, scr, lane);
        if (!hb) break;
        it = itb + nw; const bool ha = it < it1;
        if (ha) { da = tr_decode(F, it); tr_load(da, va, lane); }
        tr_store(db, vb, scr, lane);
        if (!ha) break;
    }
}
__device__ __forceinline__ int p1_idle_from(int G) { const int rem = (65 * (NGU / 256)) % G; return rem == 0 ? G : rem; }
__device__ __forceinline__ void p0_prologue(Frame& F) {
    const int lane = F.lane;
    weight_transposes(F, 0, TR_NITEMS, F.gw, F.ngw);
    bf16* XB = WSP(bf16, WS_XB); float* RS = WSP(float, WS_RS);
    for (int row0 = F.gw; row0 < XBROWS; row0 += 2 * F.ngw) {
        const float* srcs[2]; f32x4 v[2][4]; float ss[2];
#pragma unroll
        for (int u = 0; u < 2; ++u) { const int row = row0 + u * F.ngw;
            srcs[u] = row >= XBROWS ? nullptr : (row < MPR ? FP(0) + (size_t)row * D : (row < MPR + NSAMP ? FP(1) + (size_t)(row - MPR) * D : (row >= MP ? FP(2) + (size_t)(row - MP) * D : nullptr)));
#pragma unroll
            for (int j = 0; j < 4; ++j) v[u][j] = srcs[u] ? ((const f32x4*)srcs[u])[64 * j + lane] : (f32x4){0.f, 0.f, 0.f, 0.f}; }
#pragma unroll
        for (int u = 0; u < 2; ++u) { float t = 0.f;
#pragma unroll
            for (int j = 0; j < 4; ++j) t += (v[u][j].x * v[u][j].x + v[u][j].y * v[u][j].y) + (v[u][j].z * v[u][j].z + v[u][j].w * v[u][j].w);
            ss[u] = t; }
#pragma unroll
        for (int o = 1; o < 64; o <<= 1) { ss[0] += __shfl_xor(ss[0], o); ss[1] += __shfl_xor(ss[1], o); }
#pragma unroll
        for (int u = 0; u < 2; ++u) { const int row = row0 + u * F.ngw; if (row >= XBROWS) continue;
            float mul = 1.0f;
            if (row >= MP) mul = rsqrt_f(ss[u] * (1.0f / D) + EPS);
            u32x2* o8 = (u32x2*)(XB + (size_t)row * D);
#pragma unroll
            for (int j = 0; j < 4; ++j) o8[64 * j + lane] = (u32x2){cvtpk(v[u][j].x * mul, v[u][j].y * mul), cvtpk(v[u][j].z * mul, v[u][j].w * mul)};
            if (row < MP && lane < 16) RS[(size_t)row * 16 + lane] = lane == 0 ? ss[u] : 0.f;
            if (row >= MPR + NSAMP && row < MP) ((u32x4*)(WSP(unsigned char, WS_X1) + (size_t)row * D))[lane] = (u32x4){0u, 0u, 0u, 0u}; }
    }
    f32x2* rope = WSP(f32x2, WS_ROPE);
    for (int e = F.gw * 64 + lane; e < (PAST + 1) * 32; e += F.ngw * 64) {
        const int pos = e >> 5, j = e & 31;
        double inv = 1.0; for (int q = 0; q < j; ++q) inv *= 0.74989420933245582730;
        float c, s; sincos_d((double)pos * inv, c, s);
        rope[e] = (f32x2){c, s};
    }
}

__device__ __forceinline__ void idx_scores_item(int b, int qb, int kt_begin, int kt_end, const bf16* QI, const bf16* KI, const float* WI, unsigned* SC, int lane, LAS unsigned char* tl  ) {
    const int c = lane & 31, hi = lane >> 5;
    const size_t qrow0 = (size_t)b * SEQ + qb * 32, qrow = qrow0 + c;
    bf16x8 Bq[8][4];
#pragma unroll
    for (int h = 0; h < 8; ++h)
#pragma unroll
        for (int kk = 0; kk < 4; ++kk) Bq[h][kk] = ld8(QI + qrow * 512 + h * 64 + kk * 16 + hi * 8);
    const f32x4 w0 = *(const f32x4*)(WI + qrow * 8), w1 = *(const f32x4*)(WI + qrow * 8 + 4);
    const float wh[8] = {0.5f * w0[0], 0.5f * w0[1], 0.5f * w0[2], 0.5f * w0[3], 0.5f * w1[0], 0.5f * w1[1], 0.5f * w1[2], 0.5f * w1[3]};
    bf16x8 Bl[4];
#pragma unroll
    for (int kk = 0; kk < 4; ++kk) {
        float al[8] = {0.f, 0.f, 0.f, 0.f, 0.f, 0.f, 0.f, 0.f};
#pragma unroll
        for (int h = 0; h < 8; ++h) { const u32x4 q4 = __builtin_bit_cast(u32x4, Bq[h][kk]);
#pragma unroll
            for (int e = 0; e < 4; ++e) { al[2 * e] = fmaf(wh[h], bf_lo(q4[e]), al[2 * e]); al[2 * e + 1] = fmaf(wh[h], bf_hi(q4[e]), al[2 * e + 1]); } }
        const u32x4 pw = {cvtpk(al[0], al[1]), cvtpk(al[2], al[3]), cvtpk(al[4], al[5]), cvtpk(al[6], al[7])};
        Bl[kk] = __builtin_bit_cast(bf16x8, pw);
    }
    const f32x16 zero16 = {0.f, 0.f, 0.f, 0.f, 0.f, 0.f, 0.f, 0.f, 0.f, 0.f, 0.f, 0.f, 0.f, 0.f, 0.f, 0.f};
#define IDX_LOADK(A, kt_) do { const size_t krow_ = (size_t)b * SEQ + (size_t)(kt_) * 32 + c; _Pragma("unroll") for (int kk = 0; kk < 4; ++kk) A[kk] = ld8(KI + krow_ * 64 + kk * 16 + hi * 8); } while (0)
#define IDX_TILE(A, kt_) do { f32x16 sc; __builtin_amdgcn_s_setprio(1); sc = mfma32(A[0], Bl[0], zero16); _Pragma("unroll") for (int kk = 1; kk < 4; ++kk) sc = mfma32(A[kk], Bl[kk], sc); __builtin_amdgcn_s_setprio(0); \
        _Pragma("unroll") for (int h = 0; h < 8; ++h) { f32x16 a; __builtin_amdgcn_s_setprio(1); a = mfma32(A[0], Bq[h][0], zero16); _Pragma("unroll") for (int kk = 1; kk < 4; ++kk) a = mfma32(A[kk], Bq[h][kk], a); __builtin_amdgcn_s_setprio(0); \
            sc[0] = __builtin_fmaf(wh[h], __builtin_fabsf(a[0]), sc[0]);     \
            _Pragma("unroll") for (int i = 1; i < 16; ++i) asm volatile("v_fma_f32 %0, %1, |%2|, %0" : "+v"(sc[i]) : "v"(wh[h]), "v"(a[i]), "v"(sc[0])); \
            __builtin_amdgcn_sched_barrier(0); } \
        unsigned ky[16]; _Pragma("unroll") for (int i = 0; i < 16; ++i) { const unsigned u_ = __float_as_uint(sc[i]); ky[i] = u_ ^ ((unsigned)((int)u_ >> 31) | 0x80000000u); } \
        _Pragma("unroll") for (int g = 0; g < 4; ++g) *(LAS u32x4*)(tl + c * 144 + g * 32 + hi * 16) = (u32x4){ky[4 * g], ky[4 * g + 1], ky[4 * g + 2], ky[4 * g + 3]}; \
        asm volatile("s_waitcnt lgkmcnt(0)" ::: "memory"); \
        { unsigned* dstp = SC + (qrow0 + (lane >> 3)) * SEQ + (size_t)(kt_) * 32 + (lane & 7) * 4; \
          _Pragma("unroll") for (int i = 0; i < 4; ++i) *(u32x4*)(dstp + (size_t)(8 * i) * SEQ) = *(const LAS u32x4*)(tl + (8 * i + (lane >> 3)) * 144 + (lane & 7) * 16); } \
        asm volatile("s_waitcnt lgkmcnt(0)" ::: "memory"); } while (0)
    bf16x8 A0[4], A1[4];
    const int kt0 = kt_begin, ktl = kt_end - 1;
    IDX_LOADK(A0, kt0);
#pragma unroll 1
    for (int kt = kt0; kt < kt_end; kt += 2) {
        IDX_LOADK(A1, (kt + 1 < ktl ? kt + 1 : ktl));
        IDX_TILE(A0, kt);
        if (kt + 1 < kt_end) {
            IDX_LOADK(A0, (kt + 2 < ktl ? kt + 2 : ktl));
            IDX_TILE(A1, kt + 1);
        }
    }
#undef IDX_LOADK
#undef IDX_TILE
}
__device__ __forceinline__ void sample_scores_item(Frame& F, int b, int page, LAS float* qs  , int kq0 = 0, int kq1 = 2, bool reuse_q = false) {
    const int lane = F.lane; const size_t row = MPR + b;
    const int phys = page < NPAGES ? FPI(9)[b * NPAGES + page] : 0;
    const bf16* QI = WSP(bf16, WS_QI) + row * 512; const float* WI = WSP(float, WS_WI) + row * 8;
    if (!reuse_q) {
#pragma unroll
        for (int j = 0; j < 8; ++j) qs[64 * j + lane] = bf2f(QI[64 * j + lane]);
        if (lane < 8) qs[512 + lane] = WI[lane];
    }
    LDS_WAIT(); asm volatile("" ::: "memory");
    float* SSC = WSP(float, WS_SSC) + (size_t)b * SSC_LD;
    const int nk = page < NPAGES ? 2 : 1;
    for (int kq = kq0; kq < nk && kq < kq1; ++kq) {
        const float* kp; bool active = true; int kidx;
        if (page < NPAGES) { const int key = lane + 64 * kq; kp = FP(5) + ((size_t)phys * PAGE + key) * 64; kidx = page * PAGE + key; }
        else { kp = F.out + O_KIS + (size_t)b * 64; active = lane == 0; kidx = PAST; }
        float a[8] = {0.f, 0.f, 0.f, 0.f, 0.f, 0.f, 0.f, 0.f};
        if (active) {
#pragma unroll 8
            for (int d4 = 0; d4 < 16; ++d4) {
                const f32x4 kv = *(const f32x4*)(kp + 4 * d4);
#pragma unroll
                for (int h = 0; h < 8; ++h) { const f32x4 q = *(const LAS f32x4*)(qs + 64 * h + 4 * d4); a[h] = fmaf(kv[0], q[0], fmaf(kv[1], q[1], fmaf(kv[2], q[2], fmaf(kv[3], q[3], a[h])))); }
            }
            float s = 0.f;
#pragma unroll
            for (int h = 0; h < 8; ++h) s = fmaf(qs[512 + h], fmaxf(a[h], 0.f), s);
            SSC[kidx] = s;
        }
    }
    LDS_WAIT(); asm volatile("" ::: "memory");
}
__device__ __forceinline__ void ret_kv_item(Frame& F, int item) {
    const int lane = F.lane, c = lane & 31, hi = lane >> 5;
    const int tk = item & 1, tv = (item >> 1) & 1, ch = (item >> 2) & 63, bh = item >> 8;
    const bf16* A = WSP(bf16, WS_RVT) + ((size_t)bh * 64 + 32 * tv + c) * SEQ + 128 * ch + 8 * hi;
    const bf16* B = WSP(bf16, WS_RKDT) + ((size_t)bh * 64 + 32 * tk + c) * SEQ + 128 * ch + 8 * hi;
    f32x16 acc;
#pragma unroll
    for (int i = 0; i < 16; ++i) acc[i] = 0.f;
#pragma unroll
    for (int kk = 0; kk < 8; ++kk) acc = mfma32(ld8(A + 16 * kk), ld8(B + 16 * kk), acc);
    float* dst = WSP(float, WS_KVS) + ((size_t)bh * 64 + ch) * 4096 + 32 * tk + c;
#pragma unroll
    for (int r = 0; r < 16; ++r) dst[(size_t)(32 * tv + 8 * (r >> 2) + 4 * hi + (r & 3)) * 64] = acc[r];
}
constexpr int MA_KP = 144, MA_VP = 528, MA_KBYTES = 256 * MA_KP, MA_VBYTES = 64 * MA_VP;
__device__ __forceinline__ void mem_attn_wg(Frame& F, int item) {
    const int lane = F.lane, tid = F.tid, c = lane & 31, hi = lane >> 5;
    const int ig = item & 31, h = (item >> 5) & 3, b = item >> 7, it = 8 * ig + F.wave;
    {
        const bf16* MKg = WSP(bf16, WS_MK) + (size_t)(b * 4 + h) * 256 * 64; const bf16* MVg = WSP(bf16, WS_MVT) + (size_t)(b * 4 + h) * 64 * 256;
#pragma unroll
        for (int q = 0; q < 4; ++q) { const int e = tid + 512 * q, r = e >> 3, pc = e & 7; *(LAS u32x4*)(F.lds + r * MA_KP + 16 * pc) = *(const u32x4*)(MKg + r * 64 + 8 * pc); }
#pragma unroll
        for (int q = 0; q < 4; ++q) { const int e = tid + 512 * q, r = e >> 5, pc = e & 31; *(LAS u32x4*)(F.lds + MA_KBYTES + r * MA_VP + 16 * pc) = *(const u32x4*)(MVg + r * 256 + 8 * pc); }
    }
    const size_t row = (size_t)b * SEQ + it * 32 + c;
    const bf16* MQ = WSP(bf16, WS_MQ) + row * 256 + 64 * h + 8 * hi;
    bf16x8 Bq[4];
#pragma unroll
    for (int kk = 0; kk < 4; ++kk) Bq[kk] = ld8(MQ + 16 * kk);
    __syncthreads();
    const LAS unsigned char* kr = F.lds + c * MA_KP + 16 * hi; const LAS unsigned char* vr = F.lds + MA_KBYTES + c * MA_VP + 16 * hi;
    f32x16 o[2];
#pragma unroll
    for (int tv = 0; tv < 2; ++tv)
#pragma unroll
        for (int i = 0; i < 16; ++i) o[tv][i] = 0.f;
    const float sc = 0.125f * LOG2E; float sum = 0.f, mx = -INFINITY;
#pragma unroll 2
    for (int T = 0; T < 8; ++T) {
        f32x16 st;
#pragma unroll
        for (int i = 0; i < 16; ++i) st[i] = 0.f;
#pragma unroll
        for (int kk = 0; kk < 4; ++kk) st = mfma32(*(const LAS bf16x8*)(kr + T * 32 * MA_KP + 32 * kk), Bq[kk], st);
        float tm = st[0];
#pragma unroll
        for (int i = 1; i < 16; ++i) tm = fmaxf(tm, st[i]);
        tm = x32_max(tm);
        const float mn = fmaxf(mx, tm), alpha = fast_exp2((mx - mn) * sc);
        mx = mn; sum *= alpha;
#pragma unroll
        for (int tv = 0; tv < 2; ++tv)
#pragma unroll
            for (int i = 0; i < 16; ++i) o[tv][i] *= alpha;
        float ps = 0.f;
#pragma unroll
        for (int i = 0; i < 16; ++i) { const float p = fast_exp2((st[i] - mn) * sc); st[i] = p; ps += p; }
        sum += x32_sum(ps);
#pragma unroll
        for (int s2 = 0; s2 < 2; ++s2) {
            const u32x4 pw = {cvtpk(st[8 * s2], st[8 * s2 + 1]), cvtpk(st[8 * s2 + 2], st[8 * s2 + 3]), cvtpk(st[8 * s2 + 4], st[8 * s2 + 5]), cvtpk(st[8 * s2 + 6], st[8 * s2 + 7])};
            const bf16x8 pb = __builtin_bit_cast(bf16x8, pw);
#pragma unroll
            for (int tv = 0; tv < 2; ++tv) o[tv] = mfma32(*(const LAS bf16x8*)(vr + tv * 32 * MA_VP + 64 * T + 32 * s2), pb, o[tv]);
        }
    }
    const float inv = 1.0f / sum;
    bf16* CAT = WSP(bf16, WS_CAT) + row * D + 768 + 64 * h;
#pragma unroll
    for (int tv = 0; tv < 2; ++tv)
#pragma unroll
        for (int g = 0; g < 4; ++g)
            *(u32x2*)(CAT + 32 * tv + 8 * g + 4 * hi) = (u32x2){cvtpk(o[tv][4 * g] * inv, o[tv][4 * g + 1] * inv), cvtpk(o[tv][4 * g + 2] * inv, o[tv][4 * g + 3] * inv)};
    __syncthreads();
}
__device__ __forceinline__ void sample_ret_item(Frame& F, int item) {
    const int lane = F.lane, h = item & 3, b = item >> 2; const size_t row = MPR + b;
    const float kreg = bf2f(WSP(bf16, WS_RK)[row * 256 + 64 * h + lane]), qreg = bf2f(WSP(bf16, WS_RQ)[row * 256 + 64 * h + lane]), v = bf2f(WSP(bf16, WS_RV)[row * 256 + 64 * h + lane]);
    const float gam = 1.0f - exp2f(-5.0f - (float)h);
    const float* S = FP(6) + ((size_t)(b * 4 + h) * 64) * 64 + lane; float* So = F.out + O_RETS + ((size_t)(b * 4 + h) * 64) * 64 + lane;
    float o = 0.f;
    float sv[64];
#pragma unroll
    for (int dk = 0; dk < 64; ++dk) sv[dk] = S[(size_t)dk * 64];
#pragma unroll
    for (int dk = 0; dk < 64; ++dk) {
        const float kk = __shfl(kreg, dk), qq = __shfl(qreg, dk);
        const float sn = fmaf(gam, sv[dk], kk * v);
        So[(size_t)dk * 64] = sn; o = fmaf(qq, sn, o);
    }
    const float ssq = wave_sum(o * o);
    const float rn = rsqrt_f(ssq * (1.0f / 64.0f) + EPS);
    const float y = o * rn * FP(17)[64 * h + lane] * bf2f(WSP(bf16, WS_SG)[row * 256 + 64 * h + lane]);
    WSP(bf16, WS_CAT)[row * D + 512 + 64 * h + lane] = f2bf(y);
}
__device__ __forceinline__ void p5_scan(Frame& F) {
    const float* KVS = WSP(float, WS_KVS); bf16* SB = WSP(bf16, WS_SB);
    for (int e = blockIdx.x * 512 + F.tid; e < 8 * 4096; e += F.G * 512) {
        const int bh = e >> 12, r = e & 4095, h = bh & 3;
        const float g128 = exp2f(128.0f * log2_gamma(h));
        float S = 0.f; float kvv[64];
#pragma unroll
        for (int ch = 0; ch < 64; ++ch) kvv[ch] = KVS[((size_t)bh * 64 + ch) * 4096 + r];
#pragma unroll
        for (int ch = 0; ch < 64; ++ch) { SB[((size_t)bh * 64 + ch) * 4096 + r] = f2bf(S); S = fmaf(g128, S, kvv[ch]); }
        F.out[O_RETP + (size_t)bh * 4096 + (r & 63) * 64 + (r >> 6)] = S;
    }
}

__device__ __forceinline__ void ret_out_item(Frame& F, int item) {
    const int lane = F.lane, c = lane & 31, hi = lane >> 5;
    const int it = item & 3, ch = (item >> 2) & 63, bh = item >> 8, h = bh & 3, b = bh >> 2;
    const size_t tok0 = (size_t)b * SEQ + 128 * ch;
    const float lg = log2_gamma(h);
    const bf16* RQ = WSP(bf16, WS_RQ) + (tok0 + 32 * it + c) * 256 + 64 * h + 8 * hi;
    bf16x8 Bq[4];
#pragma unroll
    for (int kk = 0; kk < 4; ++kk) Bq[kk] = ld8(RQ + 16 * kk);
    f32x16 o[2];
#pragma unroll
    for (int tv = 0; tv < 2; ++tv)
#pragma unroll
        for (int i = 0; i < 16; ++i) o[tv][i] = 0.f;
    const int itu = __builtin_amdgcn_readfirstlane(it);
    const bf16* SBu = WSP(bf16, WS_SB) + ((size_t)bh * 64 + ch) * 64 * 64;
    const bf16* RKu = WSP(bf16, WS_RK) + tok0 * 256 + 64 * h;
    const bf16* RVTu = WSP(bf16, WS_RVT) + (size_t)bh * 64 * SEQ + 128 * ch;
    const unsigned sbo = (unsigned)(c * 64 + 8 * hi) * 2u, rko = (unsigned)(c * 256 + 8 * hi) * 2u, rvo = (unsigned)(c * SEQ + 8 * hi) * 2u;
#define LD8U(ubase, voff) (*(const bf16x8*)((const char*)(ubase) + (voff)))
    const bf16x8 zero8 = {0, 0, 0, 0, 0, 0, 0, 0};
    bf16x8 sbf[2][4], kf[4][4], vf[4][2][2];
#pragma unroll
    for (int tv = 0; tv < 2; ++tv)
#pragma unroll
        for (int kk = 0; kk < 4; ++kk) sbf[tv][kk] = LD8U(SBu + (size_t)tv * 32 * 64 + 16 * kk, sbo);
#pragma unroll
    for (int jt = 0; jt < 4; ++jt) {
        if (jt <= itu) {
#pragma unroll
            for (int kk = 0; kk < 4; ++kk) kf[jt][kk] = LD8U(RKu + (size_t)jt * 32 * 256 + 16 * kk, rko);
        } else {
#pragma unroll
            for (int kk = 0; kk < 4; ++kk) kf[jt][kk] = zero8;
        }
    }
#define RO_LOADV(jt) do { if ((jt) <= itu) { _Pragma("unroll") for (int s2 = 0; s2 < 2; ++s2) _Pragma("unroll") for (int tv = 0; tv < 2; ++tv) vf[jt][s2][tv] = LD8U(RVTu + (size_t)tv * 32 * SEQ + 32 * (jt) + 16 * s2, rvo); } \
        else { _Pragma("unroll") for (int s2 = 0; s2 < 2; ++s2) _Pragma("unroll") for (int tv = 0; tv < 2; ++tv) vf[jt][s2][tv] = zero8; } } while (0)
    RO_LOADV(0); RO_LOADV(1);
    asm volatile("" ::: "memory");
#pragma unroll
    for (int tv = 0; tv < 2; ++tv)
#pragma unroll
        for (int kk = 0; kk < 4; ++kk) o[tv] = mfma32(sbf[tv][kk], Bq[kk], o[tv]);
    asm volatile("" ::: "memory");
    RO_LOADV(2); RO_LOADV(3);
    asm volatile("" ::: "memory");
#undef RO_LOADV
#undef LD8U
    const int i_abs = 32 * it + c;
    { const float qd = fast_exp2((float)(i_abs + 1) * lg);
#pragma unroll
      for (int tv = 0; tv < 2; ++tv)
#pragma unroll
          for (int i = 0; i < 16; ++i) o[tv][i] *= qd; }
#pragma unroll
    for (int jt = 0; jt < 4; ++jt) {
        if (jt <= itu) {
            f32x16 st;
#pragma unroll
            for (int i = 0; i < 16; ++i) st[i] = 0.f;
#pragma unroll
            for (int kk = 0; kk < 4; ++kk) st = mfma32(kf[jt][kk], Bq[kk], st);
            int jo = 32 * jt; asm volatile("" : "+s"(jo));
#pragma unroll
            for (int r = 0; r < 16; ++r) { const int j_abs = jo + 8 * (r >> 2) + 4 * hi + (r & 3); const int df = i_abs - j_abs; st[r] = df >= 0 ? st[r] * fast_exp2((float)df * lg) : 0.f; }
#pragma unroll
            for (int s2 = 0; s2 < 2; ++s2) {
                const u32x4 pw = {cvtpk(st[8 * s2], st[8 * s2 + 1]), cvtpk(st[8 * s2 + 2], st[8 * s2 + 3]), cvtpk(st[8 * s2 + 4], st[8 * s2 + 5]), cvtpk(st[8 * s2 + 6], st[8 * s2 + 7])};
                const bf16x8 pb = __builtin_bit_cast(bf16x8, pw);
#pragma unroll
                for (int tv = 0; tv < 2; ++tv) o[tv] = mfma32(vf[jt][s2][tv], pb, o[tv]);
            }
        }
    }
    float ssq = 0.f;
#pragma unroll
    for (int tv = 0; tv < 2; ++tv)
#pragma unroll
        for (int i = 0; i < 16; ++i) ssq += o[tv][i] * o[tv][i];
    ssq = x32_sum(ssq);
#ifdef DBG_ZERO_RET
    const float rn = 0.f;
#else
    const float rn = rsqrt_f(ssq * (1.0f / 64.0f) + EPS);
#endif
    const size_t row = tok0 + 32 * it + c;
    const bf16* SG = WSP(bf16, WS_SG) + row * 256 + 64 * h; bf16* CAT = WSP(bf16, WS_CAT) + row * D + 512 + 64 * h;
#pragma unroll
    for (int tv = 0; tv < 2; ++tv)
#pragma unroll
        for (int g = 0; g < 4; ++g) {
            const int dv = 32 * tv + 8 * g + 4 * hi;
            const f32x4 gn = *(const f32x4*)(FP(17) + 64 * h + dv); const u32x2 sg = *(const u32x2*)(SG + dv);
            const float y0 = o[tv][4 * g] * rn * gn[0] * bf_lo(sg.x), y1 = o[tv][4 * g + 1] * rn * gn[1] * bf_hi(sg.x), y2 = o[tv][4 * g + 2] * rn * gn[2] * bf_lo(sg.y), y3 = o[tv][4 * g + 3] * rn * gn[3] * bf_hi(sg.y);
            *(u32x2*)(CAT + dv) = (u32x2){cvtpk(y0, y1), cvtpk(y2, y3)};
        }
}

__device__ __forceinline__ unsigned f2ord(float f) { const unsigned u = __float_as_uint(f); return (u & 0x80000000u) ? ~u : (u | 0x80000000u); }
template <int NBLK, bool BITS, typename TIn>
__device__ __forceinline__ int select_topk(const TIn* __restrict__ row, const int n_valid_, LAS unsigned* hist, LAS unsigned short* list, unsigned long long* mout, const int lane, const TIn* pf_row = nullptr, int pf_n = 0) {
    constexpr int NJ = 8 * NBLK;
    const int n_valid = __builtin_amdgcn_readfirstlane(n_valid_);
    if (n_valid <= 256) {
        if (BITS) { if (lane < 4) { const int nbits = n_valid - 64 * lane; mout[lane] = nbits >= 64 ? ~0ull : (nbits > 0 ? ((1ull << nbits) - 1ull) : 0ull); } return n_valid; }
        for (int k = lane; k < ((n_valid + 15) & ~15); k += 64) list[k] = (unsigned short)(k < n_valid ? k : 0); LDS_WAIT(); asm volatile("" ::: "memory"); return n_valid;
    }
    const int njv = (n_valid + 63) >> 6;
    int ln = lane; asm volatile("" : "+v"(ln));
    const TIn* rowl = row + ln;
    unsigned key[NJ];
#pragma unroll
    for (int qd = 0; qd < 4; ++qd) {
        constexpr int QB = (NBLK + 3) / 4;
        if (8 * QB * qd < njv) {
#pragma unroll
            for (int bk = QB * qd; bk < QB * (qd + 1) && bk < NBLK; ++bk)
#pragma unroll
                for (int jj = 0; jj < 8; ++jj) { if constexpr (__is_same(TIn, float)) key[8 * bk + jj] = __float_as_uint(rowl[64 * (8 * bk + jj)]); else key[8 * bk + jj] = (unsigned)rowl[64 * (8 * bk + jj)]; }
        } else {
#pragma unroll
            for (int bk = QB * qd; bk < QB * (qd + 1) && bk < NBLK; ++bk)
#pragma unroll
                for (int jj = 0; jj < 8; ++jj) key[8 * bk + jj] = 0u;
        }
    }
#pragma unroll
    for (int bk = 0; bk < NBLK; ++bk) {
        if constexpr (__is_same(TIn, float)) {
#pragma unroll
            for (int jj = 0; jj < 8; ++jj) { const unsigned u = key[8 * bk + jj]; key[8 * bk + jj] = u ^ ((unsigned)((int)u >> 31) | 0x80000000u); }
        }
        if (8 * bk + 8 > (n_valid >> 6)) {
#pragma unroll
            for (int jj = 0; jj < 8; ++jj) { const int j = 8 * bk + jj; key[j] = (ln < n_valid - 64 * j) ? key[j] : 0u; }
        }
    }
    unsigned pfx = 0u;
    if (pf_row) {
#pragma unroll
        for (int i = 0; i < 4; ++i) { const int e = ln * 32 + i * 2048; if (e < pf_n) pfx ^= __builtin_bit_cast(unsigned, pf_row[e]); }
    }
    unsigned g0 = 0u, g1 = 0u, g2 = 0u, g3 = 0u;
#pragma unroll
    for (int j = 0; j < NJ; ++j) { const unsigned k = key[j]; if ((j & 3) == 0) g0 = g0 > k ? g0 : k; else if ((j & 3) == 1) g1 = g1 > k ? g1 : k; else if ((j & 3) == 2) g2 = g2 > k ? g2 : k; else g3 = g3 > k ? g3 : k; }
    unsigned mx = g0 > g1 ? g0 : g1; { const unsigned t = g2 > g3 ? g2 : g3; mx = mx > t ? mx : t; }
    unsigned lb = g0 < g1 ? g0 : g1; { const unsigned t = g2 < g3 ? g2 : g3; lb = lb < t ? lb : t; }
    mx = wave_max_u_dpp(mx); lb = wave_min_u_dpp(lb);
    unsigned lo = lb > 1u ? lb : 1u, hi = mx; int need = 256; bool all_in = false;
    for (int iter = 0; iter < 8; ++iter) {
        const unsigned width = hi - lo;
        const int shift = width >= 256u ? (24 - __builtin_clz(width)) : 0;
        hist[lane] = 0u; hist[lane + 64] = 0u; hist[lane + 128] = 0u; hist[lane + 192] = 0u;
        LDS_WAIT(); asm volatile("" ::: "memory");
#pragma unroll
        for (int bk = 0; bk < NBLK; ++bk) {
            if (8 * bk < njv) {
#pragma unroll
                for (int jj = 0; jj < 8; ++jj) { const unsigned dk = key[8 * bk + jj] - lo;
                    const unsigned bin = dk <= width ? (dk >> shift) : 256u + (unsigned)ln; __hip_atomic_fetch_add(hist + bin, 1u, __ATOMIC_RELAXED, __HIP_MEMORY_SCOPE_WAVEFRONT);
#ifdef DBG_DOUBLE_ATOMIC
                    __hip_atomic_fetch_add(hist + 256u + (unsigned)ln, 1u, __ATOMIC_RELAXED, __HIP_MEMORY_SCOPE_WAVEFRONT);
#endif
                    }
            }
            __builtin_amdgcn_sched_barrier(0);
        }
        LDS_WAIT(); asm volatile("" ::: "memory");
        const u32x4 cc = *(const LAS u32x4*)(hist + 4 * lane);
        const unsigned s = (cc.x + cc.y) + (cc.z + cc.w);
        const unsigned pre = wave_prefix_sum_dpp(s);
        const unsigned tot = (unsigned)__builtin_amdgcn_readlane((int)pre, 63);
        const unsigned a3 = tot - pre, a2 = a3 + cc.w, a1 = a2 + cc.z, a0 = a1 + cc.y;
        const unsigned nd = (unsigned)need;
        int myi = -1; unsigned myab = 0u, mycnt = 0u;
        if (a3 < nd && nd <= a3 + cc.w) { myi = 3; myab = a3; mycnt = cc.w; }
        else if (a2 < nd && nd <= a2 + cc.z) { myi = 2; myab = a2; mycnt = cc.z; }
        else if (a1 < nd && nd <= a1 + cc.y) { myi = 1; myab = a1; mycnt = cc.y; }
        else if (a0 < nd && nd <= a0 + cc.x) { myi = 0; myab = a0; mycnt = cc.x; }
        const unsigned long long bm = __ballot(myi >= 0);
        if (bm == 0ull) break;
        const int owner = __builtin_amdgcn_readfirstlane(__builtin_ctzll(bm));
        const int B = 4 * owner + __builtin_amdgcn_readlane(myi, owner); const unsigned above = (unsigned)__builtin_amdgcn_readlane((int)myab, owner), nin = (unsigned)__builtin_amdgcn_readlane((int)mycnt, owner);
        need -= (int)above;
        const unsigned lo_n = lo + ((unsigned)B << shift);
        unsigned hi_n = lo_n + ((1u << shift) - 1u); if (hi_n > hi || hi_n < lo_n) hi_n = hi;
        lo = lo_n; hi = hi_n;
        if (shift == 0 || nin == (unsigned)need) { all_in = nin == (unsigned)need; break; }
    }
    int base = 0, ties = 0;
    unsigned wl[(NBLK + 7) / 8], wh[(NBLK + 7) / 8];
#pragma unroll
    for (int q = 0; q < (NBLK + 7) / 8; ++q) { wl[q] = 0u; wh[q] = 0u; }
    if (BITS && all_in) {
#pragma unroll
        for (int bk = 0; bk < NBLK; ++bk) {
            if (8 * bk < njv) {
#pragma unroll
                for (int jj = 0; jj < 8; ++jj) {
                    const int j = 8 * bk + jj;
                    const unsigned long long m_sel = __ballot(key[j] >= lo);
                    const unsigned mlo = (unsigned)m_sel, mhi = (unsigned)(m_sel >> 32);
                    asm volatile("s_nop 1\n\tv_writelane_b32 %0, %2, %4\n\tv_writelane_b32 %1, %3, %4" : "+v"(wl[j >> 6]), "+v"(wh[j >> 6]) : "s"(mlo), "s"(mhi), "i"(j & 63));
                }
            }
            __builtin_amdgcn_sched_barrier(0);
        }
    } else
#pragma unroll
    for (int bk = 0; bk < NBLK; ++bk) {
        if (8 * bk < njv) {
#pragma unroll
            for (int jj = 0; jj < 8; ++jj) {
                const int j = 8 * bk + jj; const unsigned k = key[j];
                const bool inb = (k >= lo) && (k <= hi);
                const unsigned long long m_in = __ballot(inb);
                const bool sel = (k > hi) || (inb && (ties + mbcnt64(m_in) < need));
                const unsigned long long m_sel = __ballot(sel);
                if (BITS) { const unsigned mlo = (unsigned)m_sel, mhi = (unsigned)(m_sel >> 32);
                    asm volatile("s_nop 1\n\tv_writelane_b32 %0, %2, %4\n\tv_writelane_b32 %1, %3, %4" : "+v"(wl[j >> 6]), "+v"(wh[j >> 6]) : "s"(mlo), "s"(mhi), "i"(j & 63)); }
                else if (sel) { const int pos = base + mbcnt64(m_sel); if (pos < 256) list[pos] = (unsigned short)(64 * j + ln); }
                base += __builtin_popcountll(m_sel); ties += __builtin_popcountll(m_in);
            }
        }
        __builtin_amdgcn_sched_barrier(0);
    }
    if (BITS) {
#pragma unroll
        for (int q = 0; q < (NBLK + 7) / 8; ++q) if (64 * q + ln < njv) mout[64 * q + ln] = ((unsigned long long)wh[q] << 32) | wl[q];
    }
    if (pf_row && pfx == 0x9e3779b9u) hist[256 + ln] = pfx;
    LDS_WAIT(); asm volatile("" ::: "memory");
    return base < 256 ? base : 256;
}

constexpr int AT_PITCH = 144, AT_KBYTES = 64 * AT_PITCH, AT_STAGE = 2 * AT_KBYTES, AT_NSTAGE = 3;
template <bool FIXED>
__device__ __forceinline__ void attn_dense_item(Frame& F, int b, int h, int qb, bf16* cat_base, float mfix) {
    const int tid = F.tid, lane = F.lane, w = F.wave, c = lane & 31, hi = lane >> 5;
    const int qt = 8 * qb + w;
    const size_t qrow = (size_t)b * SEQ + 32 * qt + c;
    bf16x8 Bq[4];
#pragma unroll
    for (int kk = 0; kk < 4; ++kk) Bq[kk] = ld8(WSP(bf16, WS_Q) + qrow * 512 + 64 * h + 16 * kk + 8 * hi);
    const unsigned long long* mrow = WSP(unsigned long long, WS_MASK) + qrow * 128;
    const int nt = 4 * qb + 4;
    const int sr = tid >> 3, spc = tid & 7;
    const bf16* ksrc = WSP(bf16, WS_K) + ((size_t)b * SEQ + sr) * 512 + 64 * h + 8 * spc;
    const bf16* vsrc = WSP(bf16, WS_VTA) + ((size_t)(b * 8 + h) * 64 + sr) * SEQ + 8 * spc;
    LAS unsigned char* sdst = F.lds + sr * AT_PITCH + 16 * spc;
    u32x4 kreg = *(const u32x4*)ksrc, vreg = *(const u32x4*)vsrc;
    *(LAS u32x4*)sdst = kreg; *(LAS u32x4*)(sdst + AT_KBYTES) = vreg;
    { const int t1 = nt > 1 ? 1 : 0; kreg = *(const u32x4*)(ksrc + (size_t)t1 * 64 * 512); vreg = *(const u32x4*)(vsrc + t1 * 64); }
    unsigned long long mw = mrow[0];
    f32x16 o[2];
#pragma unroll
    for (int tv = 0; tv < 2; ++tv)
#pragma unroll
        for (int i = 0; i < 16; ++i) o[tv][i] = 0.f;
    float m = -INFINITY, l = 0.f;
    const float sc = 1.0f;
    const LAS unsigned char* kread = F.lds + c * AT_PITCH + 16 * hi;
    const LAS unsigned char* vread = F.lds + AT_KBYTES + c * AT_PITCH + 16 * hi;
#define AT_QK(sd_, stg_, u_) do { _Pragma("unroll") for (int i = 0; i < 16; ++i) sd_[i] = 0.f; __builtin_amdgcn_s_setprio(1); \
        _Pragma("unroll") for (int kk = 0; kk < 4; ++kk) sd_ = mfma32(*(const LAS bf16x8*)(kread + (stg_) + 32 * (u_) * AT_PITCH + 32 * kk), Bq[kk], sd_); __builtin_amdgcn_s_setprio(0); } while (0)
#define AT_SMPV(sd_, w32_, stg_, u_) do { float mc; \
        if (FIXED) mc = 0.f; \
        else { float tm = fmaxf(fmaxf(fmaxf(sd_[0], sd_[1]), fmaxf(sd_[2], sd_[3])), fmaxf(fmaxf(sd_[4], sd_[5]), fmaxf(sd_[6], sd_[7]))); \
            tm = fmaxf(tm, fmaxf(fmaxf(fmaxf(sd_[8], sd_[9]), fmaxf(sd_[10], sd_[11])), fmaxf(fmaxf(sd_[12], sd_[13]), fmaxf(sd_[14], sd_[15])))); \
            tm = x32_max(tm); const float mn = fmaxf(m, tm), alpha = fast_exp2((m - mn) * sc); mc = mn * sc; m = mn; l *= alpha; \
            _Pragma("unroll") for (int tv = 0; tv < 2; ++tv) _Pragma("unroll") for (int i = 0; i < 16; ++i) o[tv][i] *= alpha; } \
        const unsigned Wh = (unsigned)(w32_) >> (4 * hi); float ps = 0.f; \
        _Pragma("unroll") for (int r = 0; r < 16; ++r) { const float p = FIXED ? fast_exp2(sd_[r]) : fast_exp2(sd_[r] - mc); \
            const float pm = __uint_as_float(__float_as_uint(p) & (unsigned)__builtin_amdgcn_sbfe((int)Wh, 8 * (r >> 2) + (r & 3), 1)); ps += pm; sd_[r] = pm; } \
        l += ps; __builtin_amdgcn_s_setprio(1); \
        _Pragma("unroll") for (int s2 = 0; s2 < 2; ++s2) { \
            const u32x4 pw = {cvtpk(sd_[8 * s2], sd_[8 * s2 + 1]), cvtpk(sd_[8 * s2 + 2], sd_[8 * s2 + 3]), cvtpk(sd_[8 * s2 + 4], sd_[8 * s2 + 5]), cvtpk(sd_[8 * s2 + 6], sd_[8 * s2 + 7])}; \
            const bf16x8 pb = __builtin_bit_cast(bf16x8, pw); \
            _Pragma("unroll") for (int tv = 0; tv < 2; ++tv) o[tv] = mfma32(*(const LAS bf16x8*)(vread + (stg_) + 32 * tv * AT_PITCH + 64 * (u_) + 32 * s2), pb, o[tv]); } \
        __builtin_amdgcn_s_setprio(0); } while (0)
    for (int it = 0; it < nt; ++it) {
        { LAS unsigned char* d = sdst + ((it + 1) % AT_NSTAGE) * AT_STAGE; *(LAS u32x4*)d = kreg; *(LAS u32x4*)(d + AT_KBYTES) = vreg; }
        { const int t2 = it + 2 < nt ? it + 2 : nt - 1; kreg = *(const u32x4*)(ksrc + (size_t)t2 * 64 * 512); vreg = *(const u32x4*)(vsrc + t2 * 64); }
        unsigned long long mw_next = mrow[it + 1 < nt ? it + 1 : nt - 1];
        if (2 * (it + 1) > qt) mw_next = 0ull;
        __syncthreads();
        const int stg = (it % AT_NSTAGE) * AT_STAGE;
        if (2 * it <= qt) { f32x16 s; AT_QK(s, stg, 0); AT_SMPV(s, mw, stg, 0); }
        if (2 * it + 1 <= qt) { f32x16 s; AT_QK(s, stg, 1); AT_SMPV(s, mw >> 32, stg, 1); }
        mw = mw_next;
    }
#undef AT_QK
#undef AT_SMPV
    l = x32_sum(l);
    const float inv = 1.0f / l;
    bf16* CAT = cat_base + qrow * D + 64 * h;
#pragma unroll
    for (int tv = 0; tv < 2; ++tv)
#pragma unroll
        for (int g = 0; g < 4; ++g)
            *(u32x2*)(CAT + 32 * tv + 8 * g + 4 * hi) = (u32x2){cvtpk(o[tv][4 * g] * inv, o[tv][4 * g + 1] * inv), cvtpk(o[tv][4 * g + 2] * inv, o[tv][4 * g + 3] * inv)};
    __syncthreads();
}
__device__ __forceinline__ void attn_dense_item3(Frame& F, int b, int h, int qb, bf16* cat_base) {
    const int tid = F.tid, lane = F.lane, w = F.wave, c = lane & 31, hi = lane >> 5;
    const int qt = 8 * qb + w;
    const size_t qrow = (size_t)b * SEQ + 32 * qt + c;
    bf16x8 Bq[4];
#pragma unroll
    for (int kk = 0; kk < 4; ++kk) Bq[kk] = ld8(WSP(bf16, WS_Q) + qrow * 512 + 64 * h + 16 * kk + 8 * hi);
    const unsigned long long* mrow = WSP(unsigned long long, WS_MASK) + qrow * 128;
    const int nt = 4 * qb + 4, nd = nt >> 1;
    const int sr = tid >> 3, spc = tid & 7;
    const bf16* ksrc = WSP(bf16, WS_K) + ((size_t)b * SEQ + sr) * 512 + 64 * h + 8 * spc;
    const bf16* vsrc = WSP(bf16, WS_VTA) + ((size_t)(b * 8 + h) * 64 + sr) * SEQ + 8 * spc;
    LAS unsigned char* sdst = F.lds + sr * AT_PITCH + 16 * spc;
    u32x4 kreg[2], vreg[2];
#pragma unroll
    for (int s = 0; s < 2; ++s) { kreg[s] = *(const u32x4*)(ksrc + (size_t)s * 64 * 512); vreg[s] = *(const u32x4*)(vsrc + s * 64); }
#pragma unroll
    for (int s = 0; s < 2; ++s) { *(LAS u32x4*)(sdst + s * AT_STAGE) = kreg[s]; *(LAS u32x4*)(sdst + s * AT_STAGE + AT_KBYTES) = vreg[s]; }
#pragma unroll
    for (int s = 0; s < 2; ++s) { const int t1 = 2 + s < nt ? 2 + s : nt - 1; kreg[s] = *(const u32x4*)(ksrc + (size_t)t1 * 64 * 512); vreg[s] = *(const u32x4*)(vsrc + t1 * 64); }
    unsigned long long mw[2] = {mrow[0], mrow[1]};
    f32x16 o[2];
#pragma unroll
    for (int tv = 0; tv < 2; ++tv)
#pragma unroll
        for (int i = 0; i < 16; ++i) o[tv][i] = 0.f;
    float l = 0.f;
    const LAS unsigned char* kread = F.lds + c * AT_PITCH + 16 * hi;
    const LAS unsigned char* vread = F.lds + AT_KBYTES + c * AT_PITCH + 16 * hi;
    for (int j = 0; j < nd; ++j) {
        { LAS unsigned char* d = sdst + ((j + 1) % 3) * 2 * AT_STAGE;
#pragma unroll
          for (int s = 0; s < 2; ++s) { *(LAS u32x4*)(d + s * AT_STAGE) = kreg[s]; *(LAS u32x4*)(d + s * AT_STAGE + AT_KBYTES) = vreg[s]; } }
#pragma unroll
        for (int s = 0; s < 2; ++s) { const int t2 = 2 * j + 4 + s < nt ? 2 * j + 4 + s : nt - 1; kreg[s] = *(const u32x4*)(ksrc + (size_t)t2 * 64 * 512); vreg[s] = *(const u32x4*)(vsrc + t2 * 64); }
        const unsigned long long mwn0 = mrow[2 * j + 2 < nt ? 2 * j + 2 : nt - 1], mwn1 = mrow[2 * j + 3 < nt ? 2 * j + 3 : nt - 1];
        __syncthreads();
#pragma unroll
        for (int s = 0; s < 2; ++s) {
            const int it = 2 * j + s, stg = ((j % 3) * 2 + s) * AT_STAGE;
#pragma unroll
            for (int u = 0; u < 2; ++u) {
                if (2 * it + u <= qt) {
                    f32x16 sd;
#pragma unroll
                    for (int i = 0; i < 16; ++i) sd[i] = 0.f;
                    __builtin_amdgcn_s_setprio(1);
#pragma unroll
                    for (int kk = 0; kk < 4; ++kk) sd = mfma32(*(const LAS bf16x8*)(kread + stg + 32 * u * AT_PITCH + 32 * kk), Bq[kk], sd);
                    __builtin_amdgcn_s_setprio(0);
                    const unsigned Wh = (unsigned)(mw[s] >> (32 * u)) >> (4 * hi); float ps = 0.f;
#pragma unroll
                    for (int r = 0; r < 16; ++r) { const float p = fast_exp2(sd[r]);
                        const float pm = __uint_as_float(__float_as_uint(p) & (unsigned)__builtin_amdgcn_sbfe((int)Wh, 8 * (r >> 2) + (r & 3), 1)); ps += pm; sd[r] = pm; }
                    l += ps; __builtin_amdgcn_s_setprio(1);
#pragma unroll
                    for (int s2 = 0; s2 < 2; ++s2) {
                        const u32x4 pw = {cvtpk(sd[8 * s2], sd[8 * s2 + 1]), cvtpk(sd[8 * s2 + 2], sd[8 * s2 + 3]), cvtpk(sd[8 * s2 + 4], sd[8 * s2 + 5]), cvtpk(sd[8 * s2 + 6], sd[8 * s2 + 7])};
                        const bf16x8 pb = __builtin_bit_cast(bf16x8, pw);
#pragma unroll
                        for (int tv = 0; tv < 2; ++tv) o[tv] = mfma32(*(const LAS bf16x8*)(vread + stg + 32 * tv * AT_PITCH + 64 * u + 32 * s2), pb, o[tv]);
                    }
                    __builtin_amdgcn_s_setprio(0);
                }
            }
        }
        mw[0] = mwn0; mw[1] = mwn1;
    }
    l = x32_sum(l);
    const float inv = 1.0f / l;
    bf16* CAT = cat_base + qrow * D + 64 * h;
#pragma unroll
    for (int tv = 0; tv < 2; ++tv)
#pragma unroll
        for (int g = 0; g < 4; ++g)
            *(u32x2*)(CAT + 32 * tv + 8 * g + 4 * hi) = (u32x2){cvtpk(o[tv][4 * g] * inv, o[tv][4 * g + 1] * inv), cvtpk(o[tv][4 * g + 2] * inv, o[tv][4 * g + 3] * inv)};
    __syncthreads();
}
template <bool MEM>
__device__ __forceinline__ void attend_sample_wg(Frame& F, int b, int h, LAS float* sm  ) {
    const int lane = F.lane, w = F.wave; const size_t row = MPR + b;
    LAS float* qs = sm; LAS float* sc = sm + 64; LAS float* part = sm + 320;
    const unsigned short* slist = WSP(unsigned short, WS_SLIST) + b * 256;
    if (w == 0) qs[lane] = MEM ? bf2f(WSP(bf16, WS_MQ)[row * 256 + 64 * h + lane]) : bf2f(WSP(bf16, WS_Q)[row * 512 + 64 * h + lane]);
    __syncthreads();
    if (opaque_s(w) < 4) {
        const int idx = MEM ? 64 * w + lane : (int)slist[64 * w + lane];
        const float* kp = MEM ? FP(7) + (((size_t)b * 256 + idx) * 4 + h) * 64
                              : (idx < PAST ? FP(3) + (((size_t)FPI(9)[b * NPAGES + (idx >> 7)] * PAGE + (idx & 127)) * 512 + 64 * h) : F.out + O_KS + (size_t)b * 512 + 64 * h);
        f32x4 kv[16];
#pragma unroll
        for (int d4 = 0; d4 < 16; ++d4) kv[d4] = *(const f32x4*)(kp + 4 * d4);
        float a = 0.f;
#pragma unroll
        for (int d4 = 0; d4 < 16; ++d4) { const f32x4 q = *(const LAS f32x4*)(qs + 4 * d4); a = fmaf(kv[d4][0], q[0], fmaf(kv[d4][1], q[1], fmaf(kv[d4][2], q[2], fmaf(kv[d4][3], q[3], a)))); }
        sc[64 * w + lane] = a * (MEM ? 0.125f : 1.0f / LOG2E);
    }
    __syncthreads();
    float s4[4];
#pragma unroll
    for (int m = 0; m < 4; ++m) s4[m] = sc[64 * m + lane];
    const float mx = wave_max(fmaxf(fmaxf(s4[0], s4[1]), fmaxf(s4[2], s4[3])));
    float sum = 0.f;
#pragma unroll
    for (int m = 0; m < 4; ++m) { s4[m] = fast_exp2((s4[m] - mx) * LOG2E); sum += s4[m]; }
    sum = wave_sum(sum);
    __syncthreads();
    if (w == 0) {
#pragma unroll
        for (int m = 0; m < 4; ++m) sc[64 * m + lane] = s4[m];
    }
    __syncthreads();
    float vv[32];
#pragma unroll
    for (int j = 0; j < 32; ++j) {
        const int idx = MEM ? 32 * w + j : __builtin_amdgcn_readfirstlane((int)slist[32 * w + j]);
        const float* vp = MEM ? FP(8) + (((size_t)b * 256 + idx) * 4 + h) * 64
                              : (idx < PAST ? FP(4) + (((size_t)FPI(9)[b * NPAGES + (idx >> 7)] * PAGE + (idx & 127)) * 512 + 64 * h) : F.out + O_VS + (size_t)b * 512 + 64 * h);
        vv[j] = vp[lane];
    }
    float o = 0.f;
#pragma unroll
    for (int j = 0; j < 32; ++j) o = fmaf(sc[32 * w + j], vv[j], o);
    part[64 * w + lane] = o;
    __syncthreads();
    if (w == 0) {
        float t = 0.f;
#pragma unroll
        for (int k = 0; k < 8; ++k) t += part[64 * k + lane];
        WSP(bf16, WS_CAT)[row * D + (MEM ? 768 : 0) + 64 * h + lane] = f2bf(t / sum);
    }
    __syncthreads();
}

#define N_LAUNCHES_IS_ONE (MK_N_LAUNCHES == 1)
struct Args { const void* in[26]; float* out; unsigned char* ws; int ph_lo, ph_hi; };
__device__ __forceinline__ bool SS_IN_P3(int G) { const int nr = (MIX_UNITS + G - 1) / G, first_idle = MIX_UNITS - (nr - 1) * G; return N_LAUNCHES_IS_ONE && (G - first_idle) * 4 >= G; }
constexpr int N_LAUNCHES = MK_N_LAUNCHES;

__global__ void __launch_bounds__(NWAVES * 64, 2) mk_fwd(Args args) {
    extern __shared__ __attribute__((aligned(16))) unsigned char lds[];
    Frame F;
    F.lds = (LAS unsigned char*)lds;
    F.wave = __builtin_amdgcn_readfirstlane(threadIdx.x >> 6); F.lane = hw_lane(); F.tid = (F.wave << 6) | F.lane;
    F.G = gridDim.x; F.gw = blockIdx.x * NWAVES + F.wave; F.ngw = F.G * NWAVES;
    F.ws = args.ws; F.out = args.out; F.ctl = (unsigned*)(args.ws + WS_CTL);
    F.in = args.in;

    for (int u = F.tid; u < (LDS_BYTES - LDSCTL_OFF) / 4; u += NWAVES * 64) ((LAS unsigned*)(F.lds + LDSCTL_OFF))[u] = 0u;
    __syncthreads();
    XcdBarrier bar; bar.bar = F.ctl + CW_BAR; bar.x = 0; bar.st = nullptr;
    if (N_LAUNCHES == 1) bar = xcd_barrier_post(F.ctl + CW_BAR, (volatile LAS unsigned*)(F.lds + MISC_OFF) + 8, F.tid == 0);
    const int lo = N_LAUNCHES == 1 ? 0 : args.ph_lo, hi = N_LAUNCHES == 1 ? N_PHASES : args.ph_hi;
#ifndef PH_MASK
#define PH_MASK 0x7ff
#endif
#define IN(k) (((PH_MASK >> (k)) & 1) && lo <= (k) && (k) < hi)
#define RELANE() do { F.lane = hw_lane(); F.tid = (F.wave << 6) | F.lane; } while (0)
#define SEAM(k) do { if (IN(k) && IN((k) + 1)) { xcd_barrier(bar, F.wave == 0 && hw_lane() == 0); RELANE(); } } while (0)
#ifndef REPEAT_MASK
#define REPEAT_MASK 0
#endif
#define NREP(k) ((((REPEAT_MASK) >> (k)) & 1) + 1)
#define REP(k) for (int rep = 0; rep < NREP(k); ++rep)
#define REPBAR(k) do { if (rep + 1 < NREP(k)) { xcd_barrier(bar, F.wave == 0 && hw_lane() == 0); RELANE(); } } while (0)
    LAS unsigned char* ring = F.lds;

    RELANE(); if (IN(0)) { REP(0) { p0_prologue(F); REPBAR(0); } SEAM(0); }

    RELANE(); if (IN(1)) {
        pg8::Gemm g{WSP(bf16, WS_XB), WSP(bf16, WS_WGU1), MP, NGU, D}; UpOrder S; S.init(F.G, (int)blockIdx.x, F.ctl + CW_UPFLAG1, (LAS unsigned*)(F.lds + MISC_OFF + 1024));
        EpiSwiGLU E{WSP(bf16, WS_ACT), WSP(float, WS_RS), 1.0f, nullptr};
        REP(1) { pg8::gemm_phase<EpiSwiGLU, UpOrder, true, true>(ring, g, S, E, F.tid); REPBAR(1); }
        if (skinny_early(F.G) && (int)blockIdx.x >= UP_UNITS % F.G) {
            if (F.tid == 0) { while (xb_ld(F.ctl + CW_UPFLAG1) < (unsigned)UP_FLAG_TARGET) __builtin_amdgcn_s_sleep(2); }
            __syncthreads();
            __builtin_amdgcn_fence(__ATOMIC_ACQUIRE, "agent");
            for (int grp = (int)blockIdx.x - UP_UNITS % F.G; grp < 16; grp += F.G - UP_UNITS % F.G)
                skinny_resid<FF>(F, WSP(bf16, WS_ACT) + (size_t)MPR * FF, WSP(bf16, WS_WD1), grp, WSP(bf16, WS_XB) + (size_t)MPR * D, nullptr, WSP(bf16, WS_XB) + (size_t)MPR * D, WSP(float, WS_RS) + (size_t)MPR * 16, 0.5f, (LAS float*)F.lds);
        }
        SEAM(1);
    }
    RELANE(); if (IN(2)) {
        if (!skinny_early(F.G)) for (int grp = blockIdx.x; grp < 16; grp += F.G)
            skinny_resid<FF>(F, WSP(bf16, WS_ACT) + (size_t)MPR * FF, WSP(bf16, WS_WD1), grp, WSP(bf16, WS_XB) + (size_t)MPR * D, nullptr, WSP(bf16, WS_XB) + (size_t)MPR * D, WSP(float, WS_RS) + (size_t)MPR * 16, 0.5f, (LAS float*)F.lds);
        pg8::Gemm g{WSP(bf16, WS_ACT), WSP(bf16, WS_WD1), MPR, D, FF}; pg8::StaticOrder S; S.init(MPR, D, F.G, (int)blockIdx.x);
        EpiResid E{WSP(bf16, WS_XB), WSP(bf16, WS_XB), WSP(float, WS_RS), nullptr, nullptr, 0.5f};
        REP(2) { pg8::gemm_phase<EpiResid, pg8::StaticOrder, true, true>(ring, g, S, E, F.tid); REPBAR(2); }
        SEAM(2);
    }
    RELANE(); if (IN(3)) {
        pg8::Gemm g{WSP(bf16, WS_XB), WSP(bf16, WS_WIN), XBROWS, NINX, D}; MixOrder S; S.init(F.G, (int)blockIdx.x, F.ctl + CW_SSFLAG, (LAS unsigned*)(F.lds + MISC_OFF + 1024));
        EpiMix E{WSP(float, WS_RS), FP(15), FP(16), FP(20), FP(21), WSP(float, WS_ROPE),
                 WSP(bf16, WS_Q), WSP(bf16, WS_K), WSP(bf16, WS_V), WSP(bf16, WS_QI), WSP(bf16, WS_KI), WSP(bf16, WS_RQ), WSP(bf16, WS_RK), WSP(bf16, WS_RV), WSP(bf16, WS_SG), WSP(bf16, WS_MQ),
                 WSP(bf16, WS_RKDT), WSP(bf16, WS_RVT), WSP(bf16, WS_MK), WSP(bf16, WS_MVT), WSP(float, WS_WI), F.out, WSP(bf16, WS_VTA)};
        REP(3) { pg8::gemm_phase<EpiMix, MixOrder, true, true>(ring, g, S, E, F.tid); REPBAR(3); }
        if (SS_IN_P3(F.G)) {
            const int nr = (MIX_UNITS + F.G - 1) / F.G, first_idle = MIX_UNITS - (nr - 1) * F.G;
            if ((int)blockIdx.x >= first_idle) {
                if (F.tid == 0) { while (xb_ld(F.ctl + CW_SSFLAG) < (unsigned)MIX_FLAG_TARGET) __builtin_amdgcn_s_sleep(2); }
                __syncthreads();
                __builtin_amdgcn_fence(__ATOMIC_ACQUIRE, "agent");
                const int nidw = (F.G - first_idle) * NWAVES;
                const int nitems = NSAMP * 65, whole = (nitems / nidw) * nidw, total = whole + 2 * (nitems - whole);
                const int widx = ((int)blockIdx.x - first_idle) * NWAVES + F.wave, per = whole / nidw; int prev_b = -1;
                for (int j = 0; j < per; ++j) {
                    const int it = widx * per + j, b = it / 65;
                    sample_scores_item(F, b, it % 65, (LAS float*)(F.lds + F.wave * 4096), 0, 2, b == prev_b); prev_b = b;
                }
                for (int ix = whole + widx; ix < total; ix += nidw) {
                    const int it = whole + ((ix - whole) >> 1), kq0 = (ix - whole) & 1, b = it / 65;
                    sample_scores_item(F, b, it % 65, (LAS float*)(F.lds + F.wave * 4096), kq0, kq0 + 1, b == prev_b); prev_b = b;
                }
            }
        }
        SEAM(3);
    }
    RELANE(); if (IN(4)) {
        LAS float* wl = (LAS float*)(F.lds + F.wave * 4096);
#ifndef P4_MASK
#define P4_MASK 63
#endif
        REP(4) {
#ifndef P4_REP_MASK
#define P4_REP_MASK 63
#endif
        const int p4m = rep == 0 ? P4_MASK : P4_REP_MASK;
        if ((p4m & 1) && !SS_IN_P3(F.G)) for (int it = F.gw; it < NSAMP * 65; it += F.ngw) sample_scores_item(F, it / 65, it % 65, wl);
        if (p4m & 8) for (int it = F.gw; it < 2048; it += F.ngw) ret_kv_item(F, it);
#ifndef IDX_STAGGER
#define IDX_STAGGER 3
#endif
#ifdef DBG_IDX_NOSTORE2
#define IDX_DO_STORE (rep == 0)
#else
#define IDX_DO_STORE true
#endif

        if (p4m & 32) for (int p = blockIdx.x; p < 256; p += F.G) {
            const int b = p >> 7, qa = p & 127, qz = 255 - qa, lo = (F.wave * 257) >> 3, hi = ((F.wave + 1) * 257) >> 3, na = qa + 1;
            if (lo < na) idx_scores_item(b, qa, lo, hi < na ? hi : na, WSP(bf16, WS_QI), WSP(bf16, WS_KI), WSP(float, WS_WI), WSP(unsigned, WS_SC), F.lane, F.lds + 32768 + F.wave * 4608);
            if (hi > na) idx_scores_item(b, qz, (lo > na ? lo : na) - na, hi - na, WSP(bf16, WS_QI), WSP(bf16, WS_KI), WSP(float, WS_WI), WSP(unsigned, WS_SC), F.lane, F.lds + 32768 + F.wave * 4608);
        }
        REPBAR(4); }
        SEAM(4);
    }
    RELANE(); if (IN(5)) {
        LAS unsigned char* wb = F.lds + F.wave * 14336;
        LAS unsigned* hist = (LAS unsigned*)wb; LAS unsigned short* list = (LAS unsigned short*)(wb + 1024);
        REP(5) {
#ifdef DBG_P5_SMALL2
        if (DBG_P5_SMALL2 & 1) p5_scan(F);
        if (DBG_P5_SMALL2 & 2) for (int it = blockIdx.x; it < 256; it += F.G) mem_attn_wg(F, it);
        if (DBG_P5_SMALL2 & 4) for (int it = (int)blockIdx.x - 128; it >= 0 && it < NSAMP * 4; it += F.G) attend_sample_wg<true>(F, it >> 2, it & 3, (LAS float*)(F.lds + 116736));
        if (DBG_P5_SMALL2 & 8) for (int it = F.ngw - 1 - F.gw; it < 128; it += F.ngw) sample_ret_item(F, it);
#endif
        p5_scan(F);
        for (int it = blockIdx.x; it < 256; it += F.G) mem_attn_wg(F, it);
        for (int it = (int)blockIdx.x - 128; it >= 0 && it < NSAMP * 4; it += F.G) attend_sample_wg<true>(F, it >> 2, it & 3, (LAS float*)(F.lds + 116736));
        for (int it = F.ngw - 1 - F.gw; it < 128; it += F.ngw) sample_ret_item(F, it);
        const bool selblk = (int)blockIdx.x >= 64 && (int)blockIdx.x < 64 + NSAMP;
        if (selblk && F.wave == 0) {
            const int b = (int)blockIdx.x - 64;
            (void)select_topk<17, false, float>(WSP(float, WS_SSC) + (size_t)b * SSC_LD, PAST + 1, hist, list, nullptr, F.lane);
            u32x2* dst = (u32x2*)(WSP(unsigned short, WS_SLIST) + b * 256);
            dst[F.lane] = *(const LAS u32x2*)(list + 4 * F.lane);
        }
        for (int base = F.gw; base < 2048; base += F.ngw) {
            auto qmap = [&](int qi, int& b, int& t) -> bool {
                int src = base, q = qi;
                if (qi >= 8) { if (!(selblk && (F.wave == 1 || F.wave == 2))) return false; src = base - F.wave; q = 5 + F.wave; }
                else if (selblk && F.wave == 0 && qi >= 6) return false;
                b = q >> 2; const int q4 = q & 3;
                t = q4 == 0 ? src : (q4 == 1 ? 4095 - src : (q4 == 2 ? 4096 + src : 8191 - src));
                return true;
            };
            for (int qi = 0; qi < 9; ++qi) {
                int b, t; if (!qmap(qi, b, t)) continue;
                int nb = 0, nt = 0; bool hasn = false;
                for (int q2 = qi + 1; q2 < 9 && !hasn; ++q2) hasn = qmap(q2, nb, nt);
#ifdef SEL_PREFETCH
                const unsigned* nrow = hasn ? WSP(unsigned, WS_SC) + ((size_t)nb * SEQ + nt) * SEQ : nullptr;
#else
                const unsigned* nrow = nullptr;
#endif
#ifdef DBG_SEL2
                (void)select_topk<16, true, unsigned>(WSP(unsigned, WS_SC) + ((size_t)b * SEQ + t) * SEQ, t + 1, hist, list, WSP(unsigned long long, WS_MASK) + ((size_t)b * SEQ + t) * 128, F.lane);
#endif
                (void)select_topk<16, true, unsigned>(WSP(unsigned, WS_SC) + ((size_t)b * SEQ + t) * SEQ, t + 1, hist, list, WSP(unsigned long long, WS_MASK) + ((size_t)b * SEQ + t) * 128, F.lane, nrow, hasn ? nt + 1 : 0);
            }
        }
        REPBAR(5); }
        SEAM(5);
    }
    RELANE(); if (IN(7)) {
        REP(7) {
#ifdef DBG_P7_ONCE
        if (rep == NREP(7) - 1)
#endif
        for (int it = opaque_s((int)blockIdx.x); it < NSAMP * 8; it += F.G) attend_sample_wg<false>(F, it >> 3, it & 7, (LAS float*)(F.lds + 116736));
        for (int it = opaque_s(F.gw); it < 2048; it += F.ngw) ret_out_item(F, it);
        __syncthreads();
        const float mfix = 8.0f * wave_max(fabsf(FP(15)[F.lane])) * wave_max(fabsf(FP(16)[F.lane]));
        const bool fixed_ok = mfix < 40.0f;
        for (int p = opaque_s((int)blockIdx.x); p < 256; p += F.G) {
            const int combo = (p & 7) + 8 * ((p >> 3) & 1), pr = p >> 4, b = combo >> 3, h = combo & 7;
            bf16* catb = (rep + 1 < NREP(7)) ? WSP(bf16, WS_SC) : WSP(bf16, WS_CAT);
#ifdef DBG_P7_TWICE
            if (fixed_ok) { attn_dense_item3(F, b, h, 31 - pr, catb); attn_dense_item3(F, b, h, pr, catb); }
#endif
            if (fixed_ok) { attn_dense_item3(F, b, h, 31 - pr, catb); attn_dense_item3(F, b, h, pr, catb); }
            else { attn_dense_item<false>(F, b, h, 31 - pr, catb, mfix); attn_dense_item<false>(F, b, h, pr, catb, mfix); }
        }
        REPBAR(7); }
        SEAM(7);
    }
    RELANE(); if (IN(8)) {
        for (int grp = blockIdx.x; grp < 16; grp += F.G)
            skinny_resid<D>(F, WSP(bf16, WS_CAT) + (size_t)MPR * D, WSP(bf16, WS_WOUT), grp, WSP(bf16, WS_XB) + (size_t)MPR * D, nullptr, WSP(bf16, WS_XB) + (size_t)MPR * D, WSP(float, WS_RS) + (size_t)MPR * 16, 1.0f, (LAS float*)F.lds, WSP(unsigned char, WS_X1) + (size_t)MPR * D);
        pg8::Gemm g{WSP(bf16, WS_CAT), WSP(bf16, WS_WOUT), MPR, D, D}; pg8::StaticOrder S; S.init(MPR, D, F.G, (int)blockIdx.x);
#ifdef DBG_NO_X8
        EpiResid E{WSP(bf16, WS_XB), WSP(bf16, WS_XB), WSP(float, WS_RS), nullptr, nullptr, 1.0f};
#else
        EpiResid E{WSP(bf16, WS_XB), WSP(bf16, WS_XB), WSP(float, WS_RS), nullptr, WSP(unsigned char, WS_X1), 1.0f};
#endif
        pg8::gemm_phase<EpiResid, pg8::StaticOrder, true, true>(ring, g, S, E, F.tid);
        SEAM(8);
    }
    RELANE(); if (IN(9)) {
#ifdef DBG_NO_F8
        pg8::Gemm g{WSP(bf16, WS_XB), WSP(bf16, WS_WGU2), MP, NGU, D}; pg8::StaticOrder S; S.init(MP, NGU, F.G, (int)blockIdx.x);
        EpiSwiGLU E{WSP(bf16, WS_ACT), WSP(float, WS_RS), 1.0f, nullptr};
        pg8::gemm_phase<EpiSwiGLU, pg8::StaticOrder, true, true, false>(ring, g, S, E, F.tid);
#else
        pg8::Gemm g{WSP(bf16, WS_X1), WSP(bf16, WS_WGU2), MP, NGU, D / 2}; UpOrder S; S.init(F.G, (int)blockIdx.x, F.ctl + CW_UPFLAG2, (LAS unsigned*)(F.lds + MISC_OFF + 1024));
#ifdef DBG_NO_F8D
        EpiSwiGLU E{WSP(bf16, WS_ACT), WSP(float, WS_RS), 1.0f / W8SCALE, nullptr};
#else
        EpiSwiGLU E{WSP(bf16, WS_ACT), WSP(float, WS_RS), 1.0f / W8SCALE, WSP(unsigned char, WS_ACT)};
#endif
#ifdef DBG_P9_TWICE
        pg8::gemm_phase<EpiSwiGLU, UpOrder, true, true, true>(ring, g, S, E, F.tid); xcd_barrier(bar, F.wave == 0 && hw_lane() == 0); RELANE();
#endif
        REP(9) { pg8::gemm_phase<EpiSwiGLU, UpOrder, true, true, true>(ring, g, S, E, F.tid); REPBAR(9); }
#ifndef DBG_NO_F8D
        RELANE();
        if (skinny_early(F.G) && (int)blockIdx.x >= UP_UNITS % F.G) {
            if (F.tid == 0) { while (xb_ld(F.ctl + CW_UPFLAG2) < (unsigned)UP_FLAG_TARGET) __builtin_amdgcn_s_sleep(2); }
            __syncthreads();
            __builtin_amdgcn_fence(__ATOMIC_ACQUIRE, "agent");
            for (int grp = (int)blockIdx.x - UP_UNITS % F.G; grp < 16; grp += F.G - UP_UNITS % F.G)
                skinny_resid<FF, true>(F, (const bf16*)(WSP(unsigned char, WS_ACT) + (size_t)MPR * FF), WSP(bf16, WS_WD2), grp, WSP(bf16, WS_XB) + (size_t)MPR * D, F.out + O_YS, nullptr, nullptr, 0.5f / (W8SCALE * A8SCALE), (LAS float*)F.lds);
        }
#endif
#endif
        SEAM(9);
    }
    RELANE(); if (IN(10)) {
#ifdef DBG_NO_F8D
        for (int grp = blockIdx.x; grp < 16; grp += F.G)
            skinny_resid<FF>(F, WSP(bf16, WS_ACT) + (size_t)MPR * FF, WSP(bf16, WS_WD2), grp, WSP(bf16, WS_XB) + (size_t)MPR * D, F.out + O_YS, nullptr, nullptr, 0.5f, (LAS float*)F.lds);
        pg8::Gemm g{WSP(bf16, WS_ACT), WSP(bf16, WS_WD2), MPR, D, FF}; pg8::StaticOrder S; S.init(MPR, D, F.G, (int)blockIdx.x);
        EpiResid E{WSP(bf16, WS_XB), nullptr, nullptr, F.out + O_YP, nullptr, 0.5f};
        REP(10) { pg8::gemm_phase<EpiResid, pg8::StaticOrder, true, true>(ring, g, S, E, F.tid); REPBAR(10); }
#else
        if (!skinny_early(F.G)) for (int grp = blockIdx.x; grp < 16; grp += F.G)
            skinny_resid<FF, true>(F, (const bf16*)(WSP(unsigned char, WS_ACT) + (size_t)MPR * FF), WSP(bf16, WS_WD2), grp, WSP(bf16, WS_XB) + (size_t)MPR * D, F.out + O_YS, nullptr, nullptr, 0.5f / (W8SCALE * A8SCALE), (LAS float*)F.lds);
        pg8::Gemm g{WSP(bf16, WS_ACT), WSP(bf16, WS_WD2), MPR, D, FF / 2}; pg8::StaticOrder S; S.init(MPR, D, F.G, (int)blockIdx.x);
        EpiResid E{WSP(bf16, WS_XB), nullptr, nullptr, F.out + O_YP, nullptr, 0.5f / (W8SCALE * A8SCALE)};
        REP(10) { pg8::gemm_phase<EpiResid, pg8::StaticOrder, true, true, true>(ring, g, S, E, F.tid); REPBAR(10); }
#endif
    }
#undef IN
#undef SEAM
}

extern "C" void kernel_launch(void* const* d_in, const int* in_sizes, int n_in, void* d_out, int out_size, void* d_ws, size_t ws_size, hipStream_t stream) {
    static int grid = 0;
    if (grid == 0) {
        if (n_in != 26 || (size_t)out_size != O_END || ws_size < WS_END) { fprintf(stderr, "kernel_launch: unexpected shapes: n_in %d out %d (want %zu) ws %zu (want >= %zu); nothing launched\n", n_in, out_size, (size_t)O_END, ws_size, (size_t)WS_END); grid = -1; return; }
        int dev = 0, cus = 0, per_cu = 0;
        if (hipGetDevice(&dev) != hipSuccess || hipDeviceGetAttribute(&cus, hipDeviceAttributeMultiprocessorCount, dev) != hipSuccess) { fprintf(stderr, "kernel_launch: device query failed\n"); grid = -1; return; }
        if (hipFuncSetAttribute((const void*)mk_fwd, hipFuncAttributeMaxDynamicSharedMemorySize, LDS_BYTES) != hipSuccess) { fprintf(stderr, "kernel_launch: hipFuncSetAttribute failed\n"); grid = -1; return; }
        if (hipOccupancyMaxActiveBlocksPerMultiprocessor(&per_cu, (const void*)mk_fwd, NWAVES * 64, LDS_BYTES) != hipSuccess || per_cu < 1) { fprintf(stderr, "kernel_launch: occupancy query reports %d blocks per CU\n", per_cu); }
        (void)hipGetLastError();
        grid = cus;
    }
    if (grid < 0) return;
    if (hipMemsetAsync((char*)d_ws + WS_CTL, 0, CTL_ZERO_BYTES, stream) != hipSuccess) { fprintf(stderr, "kernel_launch: memset failed\n"); return; }
    Args a{};
    for (int i = 0; i < 26; ++i) a.in[i] = d_in[i];
    a.out = (float*)d_out; a.ws = (unsigned char*)d_ws;
    for (int li = 0; li < N_LAUNCHES; ++li) {
        a.ph_lo = (N_LAUNCHES == 1) ? 0 : li; a.ph_hi = (N_LAUNCHES == 1) ? N_PHASES : li + 1;
        hipLaunchKernelGGL(mk_fwd, dim3(grid), dim3(NWAVES * 64), LDS_BYTES, stream, a);
        const hipError_t le = hipPeekAtLastError();
        if (le != hipSuccess) { fprintf(stderr, "kernel_launch: launch %d failed: %s\n", li, hipGetErrorName(le)); break; }
    }
}
```

```cpp
#include <hip/hip_runtime.h>
#include <cstdio>
#include <cstdint>

#ifndef MK_N_LAUNCHES
#define MK_N_LAUNCHES 1
#endif
namespace pg8 {
#define PG8_LAS __attribute__((address_space(3)))
typedef unsigned short bf16_t;
typedef short bf16x8 __attribute__((ext_vector_type(8)));
typedef float f32x4 __attribute__((ext_vector_type(4)));
typedef unsigned u32x4 __attribute__((ext_vector_type(4)));
typedef int i32x4 __attribute__((ext_vector_type(4)));
typedef int i32x8 __attribute__((ext_vector_type(8)));
__device__ __forceinline__ i32x8 cat8(bf16x8 lo, bf16x8 hi) { return __builtin_shufflevector(__builtin_bit_cast(i32x4, lo), __builtin_bit_cast(i32x4, hi), 0, 1, 2, 3, 4, 5, 6, 7); }
constexpr int BM = 256, BK = 64, HALF = 128, HTB = HALF * BK * 2  , STAGE_BYTES = 8 * HTB, NXCD = 8, WGM = 8;

__host__ __device__ __forceinline__ int lds_byte(int r, int c) { const int st = (r >> 4) * 2 + (c >> 5), rr = r & 15, cc = c & 31, ob = rr * 64 + cc * 2; return st * 1024 + (ob ^ (((ob >> 9) & 1) << 5)); }
__host__ __device__ __forceinline__ void stage_rc(int b, int& R, int& C) { const int st = b / 1024, sb = b % 1024, swz = sb ^ (((sb >> 9) & 1) << 5); R = (st >> 1) * 16 + swz / 64; C = (st & 1) * 32 + (swz % 64) / 2; }
__host__ __device__ __forceinline__ int perm32(int rho) { const int n = rho >> 4, i = rho & 15; return 8 * (i >> 2) + 4 * n + (i & 3); }

struct Unit { int pm, pn; };
struct Gemm { const bf16_t* A; const bf16_t* Bt; int M, N, K; };

struct StaticOrder {
    int nM, nN, nwg, G, c;
    __host__ __device__ void init(int M, int N, int G_, int c_) { nM = M / BM; nN = N / BM; nwg = nM * nN; G = G_; c = c_; }
    __host__ __device__ bool next(int i, Unit& u) const { return at((long)i * G + c, u); }
    __host__ __device__ bool at(const long L, Unit& u) const {
        if (L >= nwg) return false;
        int wgid = (int)L; { const int q = nwg / NXCD, r = nwg % NXCD, xcd = wgid % NXCD, off = wgid / NXCD; wgid = (xcd < r ? xcd * (q + 1) : r * (q + 1) + (xcd - r) * q) + off; }
        const int nig = WGM * nN, gid = wgid / nig, fm = gid * WGM, gsz = (nM - fm) < WGM ? (nM - fm) : WGM;
        u.pm = fm + ((wgid % nig) % gsz); u.pn = (wgid % nig) / gsz; return true;
    }
    __device__ __forceinline__ void a_ready(const Unit&) const {}
    __device__ __forceinline__ void done(const Unit&) const {}
};

__device__ __forceinline__ unsigned cvt_pk_bf16(float lo, float hi) { unsigned r; asm volatile("v_cvt_pk_bf16_f32 %0, %1, %2" : "=v"(r) : "v"(lo), "v"(hi)); return r; }
typedef float f32x2 __attribute__((ext_vector_type(2)));
#ifndef PG8_ASM_STAGE_ALL
#define PG8_ASM_STAGE_ALL 1
#endif
template <class Epi, class Sched, bool ALIGN_EPI = false, bool SP2 = false, bool F8 = false>
__device__ __forceinline__ void gemm_phase(PG8_LAS unsigned char* lds, const Gemm g, const Sched& S, const Epi& E, const int tid_in) {
    const int tid = tid_in, wid = __builtin_amdgcn_readfirstlane(tid >> 6), lane = tid & 63, wr = wid >> 2, wc = wid & 3, fr = lane & 15, fq = lane >> 4;
    const int K = g.K, nt = K / BK;
    unsigned voffA[2], voffB[2];
#pragma unroll
    for (int i = 0; i < 2; ++i) { int R, C; stage_rc(tid * 16 + i * 8192, R, C); const int Rb = Epi::PERM ? ((R & ~31) + perm32(R & 31)) : R;
        voffA[i] = (unsigned)(R * K + C) * 2u; voffB[i] = (unsigned)(Rb * K + C) * 2u; }
    const size_t kstep = (size_t)(BK * 2);
    const size_t hstep = (size_t)HALF * K * 2;
    const size_t tstep = 2 * hstep;
    const unsigned ldsw = (unsigned)wid * 1024u;
    const int aoff = lds_byte(wr * 64 + fr, fq * 8), boff = lds_byte(wc * 32 + fr, fq * 8);
#define PG8_SA(b, h) (((b) * 2 + (h)) * HTB)
#define PG8_SB(b, h) ((4 + (b) * 2 + (h)) * HTB)
#define PG8_STAGE(bufoff, gbase, voff) do { _Pragma("unroll") for (int _i = 0; _i < 2; ++_i) { \
        if constexpr (F8 || PG8_ASM_STAGE_ALL) { unsigned _keep; asm volatile("s_mov_b32 %0, m0\n\ts_mov_b32 m0, %3\n\ts_nop 0\n\tglobal_load_lds_dwordx4 %1, %2\n\ts_mov_b32 m0, %0" : "=&s"(_keep) : "v"((voff)[_i]), "s"((const char*)(gbase)), "s"((unsigned)(size_t)(lds + (bufoff) + ldsw + _i * 8192)) : "memory"); } \
        else __builtin_amdgcn_global_load_lds((const unsigned*)((const char*)(gbase) + (voff)[_i]), (PG8_LAS unsigned*)(lds + (bufoff) + ldsw + _i * 8192), 16, 0, 0); } } while (0)
#define PG8_LDA(dst, b, h) do { _Pragma("unroll") for (int m = 0; m < 4; ++m) _Pragma("unroll") for (int k = 0; k < 2; ++k) dst[m][k] = *(const PG8_LAS bf16x8*)(lds + PG8_SA(b, h) + aoff + m * 2048 + k * 1024); } while (0)
#define PG8_LDB(dst, b, h) do { _Pragma("unroll") for (int n = 0; n < 2; ++n) _Pragma("unroll") for (int k = 0; k < 2; ++k) dst[n][k] = *(const PG8_LAS bf16x8*)(lds + PG8_SB(b, h) + boff + n * 2048 + k * 1024); } while (0)
#define PG8_MMA(ai, bj, At, Bt) do { __builtin_amdgcn_s_setprio(1); _Pragma("unroll") for (int m = 0; m < 4; ++m) _Pragma("unroll") for (int n = 0; n < 2; ++n) { \
        if constexpr (F8) acc[ai][bj][m][n] = __builtin_amdgcn_mfma_scale_f32_16x16x128_f8f6f4(cat8(Bt[n][0], Bt[n][1]), cat8(At[m][0], At[m][1]), acc[ai][bj][m][n], 0, 0, 0, 0, 0, 0); \
        else { _Pragma("unroll") for (int k = 0; k < 2; ++k) acc[ai][bj][m][n] = __builtin_amdgcn_mfma_f32_16x16x32_bf16(Bt[n][k], At[m][k], acc[ai][bj][m][n], 0, 0, 0); } } __builtin_amdgcn_s_setprio(0); } while (0)
#define PG8_WAIT_V(n) asm volatile("s_waitcnt vmcnt(" #n ")" ::: "memory")
#define PG8_WAIT_L(n) asm volatile("s_waitcnt lgkmcnt(" #n ")" ::: "memory")
#define PG8_BAR __builtin_amdgcn_s_barrier()
#define PG8_SCHED __builtin_amdgcn_sched_barrier(0)
    Unit cur, nxt; int ui = 0;
    if (!S.next(0, cur)) return;
    f32x4 acc[2][2][4][2];
#pragma unroll
    for (int a = 0; a < 2; ++a)
#pragma unroll
        for (int b = 0; b < 2; ++b)
#pragma unroll
            for (int m = 0; m < 4; ++m)
#pragma unroll
                for (int n = 0; n < 2; ++n) acc[a][b][m][n] = (f32x4){0.f, 0.f, 0.f, 0.f};
    bf16x8 At[4][2], B0[2][2], B1[2][2];
    const char* cA = (const char*)g.A + (size_t)cur.pm * tstep; const char* cB = (const char*)g.Bt + (size_t)cur.pn * tstep;
    S.a_ready(cur);
    if constexpr (SP2) {
        PG8_STAGE(PG8_SB(0, 0), cB, voffB); PG8_STAGE(PG8_SB(0, 1), cB + hstep, voffB); PG8_STAGE(PG8_SA(0, 0), cA, voffA); PG8_STAGE(PG8_SA(0, 1), cA + hstep, voffA);
        if (wr == 1) PG8_BAR;
        PG8_WAIT_V(2); PG8_BAR;
        PG8_STAGE(PG8_SB(1, 0), cB + kstep, voffB); PG8_STAGE(PG8_SA(1, 0), cA + kstep, voffA); PG8_STAGE(PG8_SB(1, 1), cB + hstep + kstep, voffB);
        PG8_WAIT_V(6); PG8_BAR;
    } else {
        PG8_STAGE(PG8_SB(0, 0), cB, voffB); PG8_STAGE(PG8_SA(0, 0), cA, voffA); PG8_STAGE(PG8_SB(0, 1), cB + hstep, voffB); PG8_STAGE(PG8_SA(0, 1), cA + hstep, voffA);
        if (wr == 1) PG8_BAR;
        PG8_WAIT_V(4); PG8_BAR;
        PG8_STAGE(PG8_SB(1, 0), cB + kstep, voffB); PG8_STAGE(PG8_SA(1, 0), cA + kstep, voffA); PG8_STAGE(PG8_SB(1, 1), cB + hstep + kstep, voffB);
        PG8_WAIT_V(6); PG8_BAR;
    }
    for (;;) {
        const bool has_next = S.next(ui + 1, nxt);
        const char* nA = has_next ? (const char*)g.A + (size_t)nxt.pm * tstep : cA; const char* nB = has_next ? (const char*)g.Bt + (size_t)nxt.pn * tstep : cB;
        for (int t = 0; t < nt; t += 2) {
            const bool last = (t == nt - 2);
            const char* a1 = cA + (size_t)(t + 1) * kstep;
            const char* a2 = last ? nA : cA + (size_t)(t + 2) * kstep; const char* b2 = last ? nB : cB + (size_t)(t + 2) * kstep;
            const char* a3 = a2 + kstep; const char* b3 = b2 + kstep;
            if (last && has_next) S.a_ready(nxt);
            if constexpr (SP2) {
            PG8_LDB(B0, 0, 0); PG8_LDB(B1, 0, 1); PG8_SCHED; PG8_LDA(At, 0, 0); PG8_STAGE(PG8_SA(1, 1), a1 + hstep, voffA);
            PG8_WAIT_V(8); PG8_WAIT_L(0); PG8_BAR; PG8_MMA(0, 0, At, B0); PG8_MMA(0, 1, At, B1); PG8_BAR; PG8_SCHED;
            PG8_LDA(At, 0, 1); PG8_STAGE(PG8_SB(0, 0), b2, voffB); PG8_STAGE(PG8_SB(0, 1), b2 + hstep, voffB); PG8_STAGE(PG8_SA(0, 0), a2, voffA);
            PG8_WAIT_V(8); PG8_WAIT_L(0); PG8_BAR; PG8_MMA(1, 0, At, B0); PG8_MMA(1, 1, At, B1); PG8_BAR; PG8_SCHED;
            PG8_LDB(B0, 1, 0); PG8_LDB(B1, 1, 1); PG8_SCHED; PG8_LDA(At, 1, 0); PG8_STAGE(PG8_SA(0, 1), a2 + hstep, voffA);
            PG8_WAIT_V(8); PG8_WAIT_L(0); PG8_BAR; PG8_MMA(0, 0, At, B0); PG8_MMA(0, 1, At, B1); PG8_BAR; PG8_SCHED;
            PG8_LDA(At, 1, 1); PG8_STAGE(PG8_SB(1, 0), b3, voffB); PG8_STAGE(PG8_SB(1, 1), b3 + hstep, voffB); PG8_STAGE(PG8_SA(1, 0), a3, voffA);
            PG8_WAIT_V(8); PG8_WAIT_L(0); PG8_BAR; PG8_MMA(1, 0, At, B0); PG8_MMA(1, 1, At, B1); PG8_BAR; PG8_SCHED;
            } else {
            PG8_LDB(B0, 0, 0); PG8_SCHED; PG8_LDA(At, 0, 0); PG8_STAGE(PG8_SA(1, 1), a1 + hstep, voffA);
            PG8_WAIT_L(8); PG8_BAR; PG8_WAIT_L(0); PG8_MMA(0, 0, At, B0); PG8_BAR; PG8_SCHED;
            PG8_LDB(B1, 0, 1); PG8_STAGE(PG8_SB(0, 0), b2, voffB);
            PG8_BAR; PG8_WAIT_L(0); PG8_MMA(0, 1, At, B1); PG8_BAR;
            PG8_LDA(At, 0, 1); PG8_STAGE(PG8_SA(0, 0), a2, voffA);
            PG8_BAR; PG8_WAIT_L(0); PG8_MMA(1, 0, At, B0); PG8_BAR; PG8_SCHED;
            PG8_STAGE(PG8_SB(0, 1), b2 + hstep, voffB);
            PG8_WAIT_V(6); PG8_BAR; PG8_MMA(1, 1, At, B1); PG8_BAR;
            PG8_LDB(B0, 1, 0); PG8_SCHED; PG8_LDA(At, 1, 0); PG8_STAGE(PG8_SA(0, 1), a2 + hstep, voffA);
            PG8_WAIT_L(8); PG8_BAR; PG8_WAIT_L(0); PG8_MMA(0, 0, At, B0); PG8_BAR; PG8_SCHED;
            PG8_LDB(B1, 1, 1); PG8_STAGE(PG8_SB(1, 0), b3, voffB);
            PG8_BAR; PG8_WAIT_L(0); PG8_MMA(0, 1, At, B1); PG8_BAR;
            PG8_LDA(At, 1, 1); PG8_STAGE(PG8_SA(1, 0), a3, voffA);
            PG8_BAR; PG8_WAIT_L(0); PG8_MMA(1, 0, At, B0); PG8_BAR; PG8_SCHED;
            PG8_STAGE(PG8_SB(1, 1), b3 + hstep, voffB);
            PG8_WAIT_V(6); PG8_BAR; PG8_MMA(1, 1, At, B1); PG8_BAR;
            }
        }
        if constexpr (ALIGN_EPI) { if (wr == 0) PG8_BAR; }
        if constexpr (!Epi::AFTER_DRAIN) { E(acc, cur, wr, wc, fr, fq); S.done(cur); }
        if (!has_next) break;
#pragma unroll
        for (int a = 0; a < 2; ++a)
#pragma unroll
            for (int b = 0; b < 2; ++b)
#pragma unroll
                for (int m = 0; m < 4; ++m)
#pragma unroll
                    for (int n = 0; n < 2; ++n) acc[a][b][m][n] = (f32x4){0.f, 0.f, 0.f, 0.f};
        cur = nxt; cA = nA; cB = nB; ++ui;
        if constexpr (ALIGN_EPI) { if (wr == 1) PG8_BAR; }
    }
    PG8_WAIT_V(0);
    if constexpr (!ALIGN_EPI) { if (wr == 0) PG8_BAR; }
    PG8_BAR;
    if constexpr (Epi::AFTER_DRAIN) { E.fused(acc, cur, wr, wc, fr, fq, lds, wid, lane); S.done(cur); }
#undef PG8_SA
#undef PG8_SB
#undef PG8_STAGE
#undef PG8_LDA
#undef PG8_LDB
#undef PG8_MMA
#undef PG8_WAIT_V
#undef PG8_WAIT_L
#undef PG8_BAR
#undef PG8_SCHED
}
}
#define LAS_B __attribute__((address_space(3)))
#define LAS LAS_B
#define XB_TMO      128
#define XB_XCNT(j)  (256  + 64 * (j))
#define XB_XSUB(j)  (1280 + 64 * (j))
#define XB_XGEN(j)  (2304 + 64 * (j))
#define XB_TOP      3328
#define XB_TOPGEN   3392
#define XCD_BAR_WORDS 3456
#define XB_SPIN_CAP (1u << 18)

__device__ __forceinline__ unsigned xb_ld(unsigned* p)              { return __hip_atomic_load(p, __ATOMIC_RELAXED, __HIP_MEMORY_SCOPE_AGENT); }
__device__ __forceinline__ unsigned xb_add(unsigned* p, unsigned v) { return __hip_atomic_fetch_add(p, v, __ATOMIC_RELAXED, __HIP_MEMORY_SCOPE_AGENT); }
__device__ __forceinline__ unsigned xb_xcc_id() { return (unsigned)__builtin_amdgcn_s_getreg((3 << 11) | 20) & 0xFu; }
#define XB_SPIN(cond, bar) do { unsigned _sp = 0; while (cond) { __builtin_amdgcn_s_sleep(1); \
    if ((++_sp & 255u) == 0u) { if (xb_ld(&(bar)[XB_TMO])) break; if (_sp > XB_SPIN_CAP) { atomicAdd(&(bar)[XB_TMO], 1u); break; } } } } while (0)

struct XcdBarrier {
    unsigned* bar; unsigned x;
    volatile LAS unsigned* st;
};

__device__ __forceinline__ XcdBarrier xcd_barrier_post(unsigned* bar, volatile LAS unsigned* st, const bool thread0) {
    XcdBarrier b; b.bar = bar; b.x = xb_xcc_id(); b.st = st;
    if (thread0) (void)xb_add(&bar[XB_XCNT(b.x)], 1u);
    return b;
}
__device__ __forceinline__ void xcd_barrier_complete(unsigned* bar, unsigned x, unsigned& nloc, unsigned& nx) {
    const unsigned G = gridDim.x * gridDim.y * gridDim.z;
    unsigned sum, cnt, mine, sp = 0u;
    for (;;) {
        sum = 0u; cnt = 0u; mine = 0u;
#pragma unroll
        for (unsigned j = 0; j < 16; ++j) { const unsigned c = xb_ld(&bar[XB_XCNT(j)]); sum += c; cnt += (c > 0u) ? 1u : 0u; mine = (j == x) ? c : mine; }
        if (sum == G) break;
        __builtin_amdgcn_s_sleep(1);
        if ((++sp & 255u) == 0u) { if (xb_ld(&bar[XB_TMO])) break; if (sp > XB_SPIN_CAP) { atomicAdd(&bar[XB_TMO], 1u); break; } }
    }
    nloc = mine > 0u ? mine : 1u; nx = cnt > 0u ? cnt : 1u;
}

__device__ __forceinline__ void xcd_barrier(const XcdBarrier& b, const bool thread0) {
    asm volatile("s_waitcnt vmcnt(0)" ::: "memory");
    __syncthreads();
    if (thread0) {
        unsigned* bar = b.bar;
        __builtin_amdgcn_s_waitcnt(0);
        unsigned nloc = b.st[0], nx = b.st[1];
        if (nloc == 0u) { xcd_barrier_complete(bar, b.x, nloc, nx); b.st[0] = nloc; b.st[1] = nx; }
        const unsigned old = xb_add(&bar[XB_XSUB(b.x)], 1u);
        const unsigned gen = old / nloc;
        if (old + 1u == (gen + 1u) * nloc) {
            __builtin_amdgcn_fence(__ATOMIC_RELEASE, "agent");
            asm volatile("s_waitcnt vmcnt(0)" ::: "memory");
            const unsigned og = xb_add(&bar[XB_TOP], 1u);
            const unsigned tg = og / nx;
            if (og + 1u == (tg + 1u) * nx) xb_add(&bar[XB_TOPGEN], 1u);
            else XB_SPIN(xb_ld(&bar[XB_TOPGEN]) == tg, bar);
            __builtin_amdgcn_fence(__ATOMIC_ACQUIRE, "agent");
            xb_add(&bar[XB_XGEN(b.x)], 1u);
            asm volatile("s_waitcnt vmcnt(0)" ::: "memory");
        } else {
            XB_SPIN(xb_ld(&bar[XB_XGEN(b.x)]) == gen, bar);
            __builtin_amdgcn_fence(__ATOMIC_ACQUIRE, "agent");
            asm volatile("s_waitcnt vmcnt(0)" ::: "memory");
        }
    }
    __syncthreads();
}
#undef LAS

#define GAS __attribute__((address_space(1)))
#define LAS __attribute__((address_space(3)))
typedef unsigned short bf16;
typedef float f32x4 __attribute__((ext_vector_type(4)));
typedef float f32x2 __attribute__((ext_vector_type(2)));
typedef float f32x16 __attribute__((ext_vector_type(16)));
typedef short bf16x8 __attribute__((ext_vector_type(8)));
typedef unsigned u32x4 __attribute__((ext_vector_type(4)));
typedef unsigned u32x2 __attribute__((ext_vector_type(2)));
typedef __bf16 bf16x2v __attribute__((ext_vector_type(2)));
using pg8::Unit;

constexpr int NWAVES = 8;
constexpr int D = 1024, SEQ = 8192, NBATCH = 2, MPR = NBATCH * SEQ, NSAMP = 32, MP = 65 * 256, MEMT = 256, MEMROWS = NBATCH * MEMT, XBROWS = MP + MEMROWS;
constexpr int FF = 2816, NGU = 2 * FF, NIN = 14 * 256, NINX = 16 * 256;
constexpr int PAST = 8192, PAGE = 128, NPAGES = PAST / PAGE, SSC_LD = 8704;
constexpr int N_PHASES = 11;
constexpr float EPS = 1e-6f, LOG2E = 1.4426950408889634f;

constexpr size_t O_YP = 0, O_YS = O_YP + (size_t)MPR * D, O_KP = O_YS + (size_t)NSAMP * D, O_VP = O_KP + (size_t)MPR * 512, O_KIP = O_VP + (size_t)MPR * 512,
                 O_RETP = O_KIP + (size_t)MPR * 64, O_MKP = O_RETP + 2 * 4 * 64 * 64, O_MVP = O_MKP + (size_t)MEMROWS * 256, O_KS = O_MVP + (size_t)MEMROWS * 256,
                 O_VS = O_KS + NSAMP * 512, O_KIS = O_VS + NSAMP * 512, O_RETS = O_KIS + NSAMP * 64, O_END = O_RETS + (size_t)NSAMP * 4 * 64 * 64;

constexpr size_t MiB = 1u << 20;
constexpr size_t WS_CTL = 0, CTL_ZERO_BYTES = 1 * MiB;
constexpr size_t WS_WGU1 = 1 * MiB;
constexpr size_t WS_WD1  = WS_WGU1 + 11 * MiB;
constexpr size_t WS_WGU2 = WS_WD1 + 6 * MiB;
constexpr size_t WS_WD2  = WS_WGU2 + 11 * MiB;
constexpr size_t WS_WIN  = WS_WD2 + 6 * MiB;
constexpr size_t WS_WOUT = WS_WIN + 8 * MiB;
constexpr size_t WS_ROPE = WS_WOUT + 2 * MiB;
constexpr size_t WS_RS   = WS_ROPE + 3 * MiB;
constexpr size_t WS_XB   = WS_RS + 2 * MiB;
constexpr size_t WS_ACT  = WS_XB + 34 * MiB;
constexpr size_t WS_X1   = WS_ACT + 90 * MiB;
constexpr size_t WS_Q    = WS_X1 + 65 * MiB;
constexpr size_t WS_K    = WS_Q + 17 * MiB;
constexpr size_t WS_V    = WS_K + 17 * MiB;
constexpr size_t WS_QI   = WS_V + 17 * MiB;
constexpr size_t WS_KI   = WS_QI + 17 * MiB;
constexpr size_t WS_WI   = WS_KI + 3 * MiB;
constexpr size_t WS_RQ   = WS_WI + 1 * MiB;
constexpr size_t WS_RK   = WS_RQ + 9 * MiB;
constexpr size_t WS_RV   = WS_RK + 9 * MiB;
constexpr size_t WS_SG   = WS_RV + 9 * MiB;
constexpr size_t WS_MQ   = WS_SG + 9 * MiB;
constexpr size_t WS_RKDT = WS_MQ + 9 * MiB;
constexpr size_t WS_RVT  = WS_RKDT + 8 * MiB;
constexpr size_t WS_MK   = WS_RVT + 8 * MiB;
constexpr size_t WS_MVT  = WS_MK + 1 * MiB;
constexpr size_t WS_KVS  = WS_MVT + 1 * MiB;
constexpr size_t WS_SB   = WS_KVS + 8 * MiB;
constexpr size_t WS_CAT  = WS_SB + 4 * MiB;
constexpr size_t WS_SSC  = WS_CAT + 33 * MiB;
constexpr size_t WS_SLIST = WS_SSC + 2 * MiB - 65536;
constexpr size_t WS_VTA  = WS_SSC + 2 * MiB;
constexpr size_t WS_MASK = WS_VTA + 16 * MiB;
constexpr size_t WS_SC   = WS_MASK + 16 * MiB;
constexpr size_t WS_END  = WS_SC + 512 * MiB;
constexpr int CW_BAR = 4096, CW_QUEUE = 64, CW_SSFLAG = 96, CW_UPFLAG1 = 128, CW_UPFLAG2 = 160;

constexpr int RING_BYTES = 131072, LDSCTL_OFF = RING_BYTES, MISC_OFF = LDSCTL_OFF + 320, LDS_BYTES = 147456;

#define LDS_WAIT() asm volatile("s_waitcnt lgkmcnt(0)" ::: "memory")
#define VM_WAIT() asm volatile("s_waitcnt vmcnt(0)" ::: "memory")

__device__ __forceinline__ unsigned cvtpk(float lo, float hi) { const f32x2 v = {lo, hi}; const bf16x2v b = __builtin_convertvector(v, bf16x2v); return __builtin_bit_cast(unsigned, b); }
__device__ __forceinline__ unsigned pkh(float lo, float hi) { typedef _Float16 h2 __attribute__((ext_vector_type(2))); const h2 v = {(_Float16)lo, (_Float16)hi}; return __builtin_bit_cast(unsigned, v); }
__device__ __forceinline__ float bf_lo(unsigned w) { return __uint_as_float(w << 16); }
__device__ __forceinline__ float bf_hi(unsigned w) { return __uint_as_float(w & 0xffff0000u); }
__device__ __forceinline__ float bf2f(bf16 h) { return __uint_as_float((unsigned)h << 16); }
__device__ __forceinline__ bf16 f2bf(float f) { return (bf16)(cvtpk(f, 0.f) & 0xffffu); }
__device__ __forceinline__ float fast_exp2(float x) { return __builtin_amdgcn_exp2f(x); }
__device__ __forceinline__ float fast_rcp(float x) { return __builtin_amdgcn_rcpf(x); }
__device__ __forceinline__ float silu_f(float x) { return x * fast_rcp(1.f + fast_exp2(-LOG2E * x)); }
__device__ __forceinline__ float rsqrt_f(float x) { return 1.0f / sqrtf(x); }
template <int CTRL> __device__ __forceinline__ float dpp(float x) { return __builtin_bit_cast(float, __builtin_amdgcn_mov_dpp(__builtin_bit_cast(int, x), CTRL, 0xf, 0xf, true)); }
constexpr int XOR1 = 0xB1, XOR2 = 0x4E, XOR7 = 0x141;
__device__ __forceinline__ float sum8(float x) { x += dpp<XOR1>(x); x += dpp<XOR2>(x); x += dpp<XOR7>(x); return x; }
__device__ __forceinline__ float max8(float x) { x = fmaxf(x, dpp<XOR1>(x)); x = fmaxf(x, dpp<XOR2>(x)); x = fmaxf(x, dpp<XOR7>(x)); return x; }
__device__ __forceinline__ float xrow16_sum(float x) {
    auto s = __builtin_amdgcn_permlane16_swap(__float_as_uint(x), __float_as_uint(x), false, false);
    x = __uint_as_float(s[0]) + __uint_as_float(s[1]);
    auto t = __builtin_amdgcn_permlane32_swap(__float_as_uint(x), __float_as_uint(x), false, false);
    return __uint_as_float(t[0]) + __uint_as_float(t[1]);
}
__device__ __forceinline__ float x32_sum(float x) { auto t = __builtin_amdgcn_permlane32_swap(__float_as_uint(x), __float_as_uint(x), false, false); return __uint_as_float(t[0]) + __uint_as_float(t[1]); }
__device__ __forceinline__ float x32_max(float x) { auto t = __builtin_amdgcn_permlane32_swap(__float_as_uint(x), __float_as_uint(x), false, false); return fmaxf(__uint_as_float(t[0]), __uint_as_float(t[1])); }
__device__ __forceinline__ float wave_sum(float v) {
#pragma unroll
    for (int o = 1; o < 64; o <<= 1) v += __shfl_xor(v, o);
    return v;
}
__device__ __forceinline__ float wave_max(float v) {
#pragma unroll
    for (int o = 1; o < 64; o <<= 1) v = fmaxf(v, __shfl_xor(v, o));
    return v;
}
__device__ __forceinline__ unsigned wave_max_u(unsigned v) {
#pragma unroll
    for (int o = 1; o < 64; o <<= 1) { const unsigned t = (unsigned)__shfl_xor((int)v, o); v = v > t ? v : t; }
    return v;
}
__device__ __forceinline__ unsigned wave_min_u(unsigned v) {
#pragma unroll
    for (int o = 1; o < 64; o <<= 1) { const unsigned t = (unsigned)__shfl_xor((int)v, o); v = v < t ? v : t; }
    return v;
}
template <int CTRL, int ROWMASK> __device__ __forceinline__ unsigned dpp0(unsigned v) { return (unsigned)__builtin_amdgcn_update_dpp(0, (int)v, CTRL, ROWMASK, 0xf, false); }
__device__ __forceinline__ unsigned wave_max_u_dpp(unsigned v) {
    unsigned t;
    t = dpp0<0x111, 0xf>(v); v = v > t ? v : t;  t = dpp0<0x112, 0xf>(v); v = v > t ? v : t;
    t = dpp0<0x114, 0xf>(v); v = v > t ? v : t;  t = dpp0<0x118, 0xf>(v); v = v > t ? v : t;
    t = dpp0<0x142, 0xa>(v); v = v > t ? v : t;  t = dpp0<0x143, 0xc>(v); v = v > t ? v : t;
    return (unsigned)__builtin_amdgcn_readlane((int)v, 63);
}
__device__ __forceinline__ unsigned wave_min_u_dpp(unsigned v) { return ~wave_max_u_dpp(~v); }
__device__ __forceinline__ unsigned wave_prefix_sum_dpp(unsigned v) {
    v += dpp0<0x111, 0xf>(v); v += dpp0<0x112, 0xf>(v); v += dpp0<0x114, 0xf>(v); v += dpp0<0x118, 0xf>(v);
    v += dpp0<0x142, 0xa>(v); v += dpp0<0x143, 0xc>(v);
    return v;
}
__device__ __forceinline__ int mbcnt64(unsigned long long m) { return (int)__builtin_amdgcn_mbcnt_hi((unsigned)(m >> 32), __builtin_amdgcn_mbcnt_lo((unsigned)m, 0u)); }
__device__ __forceinline__ f32x16 mfma32(bf16x8 a, bf16x8 b, f32x16 c) { return __builtin_amdgcn_mfma_f32_32x32x16_bf16(a, b, c, 0, 0, 0); }
__device__ __forceinline__ float dot2bf(unsigned k, unsigned q, float acc) {
    return __builtin_amdgcn_fdot2_f32_bf16(__builtin_bit_cast(bf16x2v, k), __builtin_bit_cast(bf16x2v, q), acc, false);
}
__device__ __forceinline__ bf16x8 ld8(const bf16* p) { return *(const bf16x8*)p; }
__device__ __forceinline__ int perm_pos(int j) { return (j & ~31) | (j & 16) | (((j >> 2) & 1) << 3) | (((j >> 3) & 1) << 2) | (j & 3); }
__device__ __forceinline__ float log2_gamma(int h) { return __log2f(1.0f - exp2f(-5.0f - (float)h)); }

__device__ __forceinline__ void store_tr4(bf16* rowbase  , size_t ld, f32x4 v, int fr) {
    const unsigned A = cvtpk(v[0], v[1]), B = cvtpk(v[2], v[3]);
    const unsigned Ap = (unsigned)__builtin_amdgcn_mov_dpp((int)A, XOR1, 0xf, 0xf, true), Bp = (unsigned)__builtin_amdgcn_mov_dpp((int)B, XOR1, 0xf, 0xf, true);
    const unsigned sel1 = (fr & 1) ? 0x03020706u : 0x05040100u;
    const unsigned A1 = __builtin_amdgcn_perm(Ap, A, sel1), B1 = __builtin_amdgcn_perm(Bp, B, sel1);
    const bool up = (fr & 2) != 0;
    const unsigned X = up ? A1 : B1;
    const unsigned R = (unsigned)__builtin_amdgcn_mov_dpp((int)X, XOR2, 0xf, 0xf, true);
    *(u32x2*)(rowbase + (size_t)(fr & 3) * ld) = (u32x2){up ? R : A1, up ? B1 : R};
}

constexpr float W8SCALE = 32.0f;
constexpr float A8SCALE = 4.0f;
__device__ __forceinline__ unsigned cvtpk_fp8x4(float a, float b, float c, float d) { int w = 0; w = __builtin_amdgcn_cvt_pk_fp8_f32(a, b, w, false); w = __builtin_amdgcn_cvt_pk_fp8_f32(c, d, w, true); return (unsigned)w; }
__device__ __forceinline__ float row_rstd(const float* rs, int row) {
    const f32x4* p = (const f32x4*)(rs + (size_t)row * 16);
    const f32x4 a = p[0], b = p[1], c = p[2], d = p[3];
    const float s = (((a.x + a.y) + (a.z + a.w)) + ((b.x + b.y) + (b.z + b.w))) + (((c.x + c.y) + (c.z + c.w)) + ((d.x + d.y) + (d.z + d.w)));
    return rsqrt_f(s * (1.0f / D) + EPS);
}

struct EpiSwiGLU {
    static constexpr bool PERM = true, AFTER_DRAIN = false;
    bf16* O; const float* rs; float wscale; unsigned char* O8;
    __device__ __forceinline__ void operator()(const f32x4 (&acc)[2][2][4][2], const Unit& u, int wr, int wc, int fr, int fq) const {
        const int row0 = u.pm * 256 + wr * 64 + fr, col0 = u.pn * 128 + wc * 32 + 8 * fq;
#pragma unroll
        for (int ai = 0; ai < 2; ++ai)
#pragma unroll
            for (int m = 0; m < 4; ++m) {
                const int row = row0 + ai * 128 + m * 16; const float r = row_rstd(rs, row) * wscale;
                unsigned w[4];
                if (O8) {
#pragma unroll
                    for (int n = 0; n < 2; ++n) {
                        const f32x4 g = acc[ai][0][m][n] * r, up = acc[ai][1][m][n] * (r * A8SCALE);
                        w[n] = cvtpk_fp8x4(silu_f(g[0]) * up[0], silu_f(g[1]) * up[1], silu_f(g[2]) * up[2], silu_f(g[3]) * up[3]);
                    }
                    *(u32x2*)(O8 + (size_t)row * FF + col0) = (u32x2){w[0], w[1]};
                } else {
#pragma unroll
                for (int n = 0; n < 2; ++n) {
                    const f32x4 g = acc[ai][0][m][n] * r, up = acc[ai][1][m][n] * r;
                    w[2 * n] = cvtpk(silu_f(g[0]) * up[0], silu_f(g[1]) * up[1]); w[2 * n + 1] = cvtpk(silu_f(g[2]) * up[2], silu_f(g[3]) * up[3]);
                }
                *(u32x4*)(O + (size_t)row * FF + col0) = (u32x4){w[0], w[1], w[2], w[3]};
                }
            }
    }
};

struct EpiResid {
    static constexpr bool PERM = true, AFTER_DRAIN = false;
    const bf16* inb; bf16* xb; float* rs; float* outf; unsigned char* x8; float scale;
    __device__ __forceinline__ void operator()(const f32x4 (&acc)[2][2][4][2], const Unit& u, int wr, int wc, int fr, int fq) const {
        const int row0 = u.pm * 256 + wr * 64 + fr, colb = u.pn * 256 + wc * 32 + 8 * fq;
#pragma unroll
        for (int ai = 0; ai < 2; ++ai)
#pragma unroll
            for (int m = 0; m < 4; ++m) {
                const int row = row0 + ai * 128 + m * 16;
                float ssq = 0.f;
#pragma unroll
                for (int bj = 0; bj < 2; ++bj) {
                    const int col = colb + bj * 128;
                    const u32x4 rb = *(const u32x4*)(inb + (size_t)row * D + col);
                    const f32x4 r0 = {bf_lo(rb[0]), bf_hi(rb[0]), bf_lo(rb[1]), bf_hi(rb[1])}, r1 = {bf_lo(rb[2]), bf_hi(rb[2]), bf_lo(rb[3]), bf_hi(rb[3])};
                    const f32x4 v0 = r0 + acc[ai][bj][m][0] * scale, v1 = r1 + acc[ai][bj][m][1] * scale;
                    if (outf) { *(f32x4*)(outf + (size_t)row * D + col) = v0; *(f32x4*)(outf + (size_t)row * D + col + 4) = v1; }
                    if (xb) *(u32x4*)(xb + (size_t)row * D + col) = (u32x4){cvtpk(v0[0], v0[1]), cvtpk(v0[2], v0[3]), cvtpk(v1[0], v1[1]), cvtpk(v1[2], v1[3])};
                    if (x8) *(u32x2*)(x8 + (size_t)row * D + col) = (u32x2){cvtpk_fp8x4(v0[0], v0[1], v0[2], v0[3]), cvtpk_fp8x4(v1[0], v1[1], v1[2], v1[3])};
                    ssq += ((v0[0] * v0[0] + v0[1] * v0[1]) + (v0[2] * v0[2] + v0[3] * v0[3])) + ((v1[0] * v1[0] + v1[1] * v1[1]) + (v1[2] * v1[2] + v1[3] * v1[3]));
                }
                if (rs) { ssq = xrow16_sum(ssq); if (fq == 0) rs[(size_t)row * 16 + u.pn * 4 + wc] = ssq; }
            }
    }
};

constexpr float QPRESCALE = 0.125f * LOG2E;
struct EpiMix {
    static constexpr bool PERM = true, AFTER_DRAIN = false;
    const float* rs; const float* gq; const float* gk; const float* gmq; const float* gmk; const float* rope;
    bf16 *Q, *K, *V, *QI, *KI, *RQ, *RK, *RV, *SG, *MQ, *RKDT, *RVT, *MK, *MVT; float* WI; float* out; bf16* VTA;
    __device__ __forceinline__ void operator()(const f32x4 (&acc)[2][2][4][2], const Unit& u, int wr, int wc, int fr, int fq) const {
        const int pn = u.pn, pm = u.pm;
        const int row0 = pm * 256 + wr * 64 + fr;
        const int dl = 8 * fq;
        const float* gptr = (pn < 2) ? gq : (pn < 4 ? gk : (pn == 12 ? gmq : (pn == 14 ? gmk : nullptr)));
        f32x4 gv[2][2];
#pragma unroll
        for (int bj = 0; bj < 2; ++bj)
#pragma unroll
            for (int n = 0; n < 2; ++n) gv[bj][n] = gptr ? *(const f32x4*)(gptr + 32 * bj + dl + 4 * n) * (pn < 2 ? QPRESCALE : 1.0f) : (f32x4){1.f, 1.f, 1.f, 1.f};
        const float lg = log2_gamma(wc);
#pragma unroll
        for (int ai = 0; ai < 2; ++ai)
#pragma unroll
            for (int m = 0; m < 4; ++m) {
                const int row = row0 + ai * 128 + m * 16;
                const float r = (pm < 65) ? row_rstd(rs, row) : 1.0f;
                f32x4 x[2][2];
#pragma unroll
                for (int bj = 0; bj < 2; ++bj)
#pragma unroll
                    for (int n = 0; n < 2; ++n) x[bj][n] = acc[ai][bj][m][n] * r;
                if (gptr) {
                    float ssq = 0.f;
#pragma unroll
                    for (int bj = 0; bj < 2; ++bj)
#pragma unroll
                        for (int n = 0; n < 2; ++n) ssq += (x[bj][n][0] * x[bj][n][0] + x[bj][n][1] * x[bj][n][1]) + (x[bj][n][2] * x[bj][n][2] + x[bj][n][3] * x[bj][n][3]);
                    ssq = xrow16_sum(ssq);
                    const float rn = rsqrt_f(ssq * (1.0f / 64.0f) + EPS);
#pragma unroll
                    for (int bj = 0; bj < 2; ++bj)
#pragma unroll
                        for (int n = 0; n < 2; ++n) x[bj][n] = x[bj][n] * rn * gv[bj][n];
                }
                if (pn == 8 || pn == 9) {
                    const int pos = row < MPR ? (row & (SEQ - 1)) : PAST;
                    const f32x4* rp = (const f32x4*)(rope + ((size_t)pos * 32 + dl) * 2);
                    const float sc = (pn == 9) ? 0.125f : 1.0f;
#pragma unroll
                    for (int n = 0; n < 2; ++n) {
                        const f32x4 cs0 = rp[2 * n], cs1 = rp[2 * n + 1];
                        const f32x4 a = x[0][n], b = x[1][n];
                        x[0][n] = (f32x4){(a[0] * cs0[0] - b[0] * cs0[1]) * sc, (a[1] * cs0[2] - b[1] * cs0[3]) * sc, (a[2] * cs1[0] - b[2] * cs1[1]) * sc, (a[3] * cs1[2] - b[3] * cs1[3]) * sc};
                        x[1][n] = (f32x4){(a[0] * cs0[1] + b[0] * cs0[0]) * sc, (a[1] * cs0[3] + b[1] * cs0[2]) * sc, (a[2] * cs1[1] + b[2] * cs1[0]) * sc, (a[3] * cs1[3] + b[3] * cs1[2]) * sc};
                    }
                }
                if (pn == 11) {
#pragma unroll
                    for (int bj = 0; bj < 2; ++bj)
#pragma unroll
                        for (int n = 0; n < 2; ++n) x[bj][n] = (f32x4){silu_f(x[bj][n][0]), silu_f(x[bj][n][1]), silu_f(x[bj][n][2]), silu_f(x[bj][n][3])};
                }
                if (pm >= 65) {
                    const int b = pm - 65, j = row - pm * 256;
                    float* of = out + (pn == 14 ? O_MKP : O_MVP) + ((size_t)(b * 256 + j) * 4 + wc) * 64;
#pragma unroll
                    for (int bj = 0; bj < 2; ++bj) { *(f32x4*)(of + 32 * bj + dl) = x[bj][0]; *(f32x4*)(of + 32 * bj + dl + 4) = x[bj][1]; }
                    if (pn == 14) {
                        bf16* ob = MK + ((size_t)(b * 4 + wc) * 256 + j) * 64;
#pragma unroll
                        for (int bj = 0; bj < 2; ++bj) *(u32x4*)(ob + 32 * bj + dl) = (u32x4){cvtpk(x[bj][0][0], x[bj][0][1]), cvtpk(x[bj][0][2], x[bj][0][3]), cvtpk(x[bj][1][0], x[bj][1][1]), cvtpk(x[bj][1][2], x[bj][1][3])};
                    } else {
                        const int pp = perm_pos(j);
#pragma unroll
                        for (int bj = 0; bj < 2; ++bj)
#pragma unroll
                            for (int n = 0; n < 2; ++n)
#pragma unroll
                                for (int i = 0; i < 4; ++i) MVT[((size_t)(b * 4 + wc) * 64 + 32 * bj + dl + 4 * n + i) * 256 + pp] = f2bf(x[bj][n][i]);
                    }
                    continue;
                }
                if (pn == 13) {
                    if (wc == 0) {
                        bf16* ob = KI + (size_t)row * 64;
#pragma unroll
                        for (int bj = 0; bj < 2; ++bj) *(u32x4*)(ob + 32 * bj + dl) = (u32x4){cvtpk(x[bj][0][0], x[bj][0][1]), cvtpk(x[bj][0][2], x[bj][0][3]), cvtpk(x[bj][1][0], x[bj][1][1]), cvtpk(x[bj][1][2], x[bj][1][3])};
                        float* of = row < MPR ? out + O_KIP + (size_t)row * 64 : (row < MPR + NSAMP ? out + O_KIS + (size_t)(row - MPR) * 64 : nullptr);
                        if (of) {
#pragma unroll
                            for (int bj = 0; bj < 2; ++bj) { *(f32x4*)(of + 32 * bj + dl) = x[bj][0]; *(f32x4*)(of + 32 * bj + dl + 4) = x[bj][1]; }
                        }
                    } else if (wc == 1 && fq == 0) {
                        const float s = 0.04419417382415922f;
                        *(f32x4*)(WI + (size_t)row * 8) = x[0][0] * s; *(f32x4*)(WI + (size_t)row * 8 + 4) = x[0][1] * s;
                    }
                    continue;
                }
                bf16* ob;
                if (pn < 2) ob = Q + (size_t)row * 512 + pn * 256;
                else if (pn < 4) ob = K + (size_t)row * 512 + (pn - 2) * 256;
                else if (pn < 6) ob = V + (size_t)row * 512 + (pn - 4) * 256;
                else if (pn < 8) ob = QI + (size_t)row * 512 + (pn - 6) * 256;
                else if (pn == 8) ob = RQ + (size_t)row * 256;
                else if (pn == 9) ob = RK + (size_t)row * 256;
                else if (pn == 10) ob = RV + (size_t)row * 256;
                else if (pn == 11) ob = SG + (size_t)row * 256;
                else ob = MQ + (size_t)row * 256;
                ob += 64 * wc;
                if (!((pn == 4 || pn == 5) || (pn == 10 && row < MPR))) {
#pragma unroll
                    for (int bj = 0; bj < 2; ++bj) *(u32x4*)(ob + 32 * bj + dl) = (u32x4){cvtpk(x[bj][0][0], x[bj][0][1]), cvtpk(x[bj][0][2], x[bj][0][3]), cvtpk(x[bj][1][0], x[bj][1][1]), cvtpk(x[bj][1][2], x[bj][1][3])};
                }
                if (pn >= 2 && pn < 6) {
                    const size_t ocol = (size_t)((pn & 1) * 256 + 64 * wc);
                    float* of = row < MPR ? out + (pn < 4 ? O_KP : O_VP) + (size_t)row * 512 + ocol : (row < MPR + NSAMP ? out + (pn < 4 ? O_KS : O_VS) + (size_t)(row - MPR) * 512 + ocol : nullptr);
                    if (of) {
#pragma unroll
                        for (int bj = 0; bj < 2; ++bj) { *(f32x4*)(of + 32 * bj + dl) = x[bj][0]; *(f32x4*)(of + 32 * bj + dl + 4) = x[bj][1]; }
                    }
                }
                if ((pn == 4 || pn == 5) && row < MPR) {
                    const int b = row >> 13, t = row & (SEQ - 1);
                    bf16* ot = VTA + ((size_t)(b * 8 + 4 * (pn - 4) + wc) * 64) * SEQ + perm_pos(t & ~3);
#pragma unroll
                    for (int bj = 0; bj < 2; ++bj)
#pragma unroll
                        for (int n = 0; n < 2; ++n) store_tr4(ot + (size_t)(32 * bj + dl + 4 * n) * SEQ, SEQ, x[bj][n], fr);
                }
                if ((pn == 9 || pn == 10) && row < MPR) {
                    const int b = row >> 13, t = row & (SEQ - 1), j = t & 127;
                    const size_t pos = (size_t)(t & ~127) + perm_pos(j & ~3);
                    const float dec = (pn == 9) ? fast_exp2((float)(127 - j) * lg) : 1.0f;
                    bf16* ot = (pn == 9 ? RKDT : RVT) + ((size_t)(b * 4 + wc) * 64) * SEQ + pos;
#pragma unroll
                    for (int bj = 0; bj < 2; ++bj)
#pragma unroll
                        for (int n = 0; n < 2; ++n) store_tr4(ot + (size_t)(32 * bj + dl + 4 * n) * SEQ, SEQ, x[bj][n] * dec, fr);
                }
            }
    }
};

__device__ __forceinline__ void publish_unit(unsigned* flag, LAS unsigned* lcnt) {
    asm volatile("s_waitcnt vmcnt(0)" ::: "memory");
    const bool lane0 = __builtin_amdgcn_mbcnt_hi(~0u, __builtin_amdgcn_mbcnt_lo(~0u, 0u)) == 0u;
    unsigned old = 0u;
    if (lane0) old = __hip_atomic_fetch_add(lcnt, 1u, __ATOMIC_RELAXED, __HIP_MEMORY_SCOPE_WORKGROUP);
    old = (unsigned)__builtin_amdgcn_readfirstlane((int)old);
    if (old == (unsigned)(NWAVES - 1)) {
        __builtin_amdgcn_fence(__ATOMIC_RELEASE, "agent");
        asm volatile("s_waitcnt vmcnt(0)" ::: "memory");
        if (lane0) { __hip_atomic_store(lcnt, 0u, __ATOMIC_RELAXED, __HIP_MEMORY_SCOPE_WORKGROUP); (void)xb_add(flag, (unsigned)NWAVES); }
    }
}
constexpr int MIX_UNITS = 14 + 64 * 14 + 4, MIX_FLAG_TARGET = 14 * NWAVES;
struct MixOrder {
    pg8::StaticOrder S; int G, c; unsigned* flag; LAS unsigned* lcnt;
    __device__ void init(int G_, int c_, unsigned* flag_, LAS unsigned* lcnt_) { S.init(MPR, NIN, G_, c_); G = G_; c = c_; flag = flag_; lcnt = lcnt_; }
    __device__ bool next(int i, Unit& u) const {
        const int L = i * G + c, head = G > 14 ? G - 14 : 0;
        if (L >= head && L < head + 14) { u.pm = 64; u.pn = L - head; return true; }
        const int P = L < head ? L : L - 14;
        if (P < S.nwg) return S.at(P, u);
        const int e = P - S.nwg; if (e >= 4) return false;
        u.pm = 65 + (e >> 1); u.pn = 14 + (e & 1); return true;
    }
    __device__ __forceinline__ void a_ready(const Unit&) const {}
    __device__ __forceinline__ void done(const Unit& u) const {
        if (u.pm == 64) publish_unit(flag, lcnt);
    }
};

constexpr int UP_UNITS = 65 * (NGU / 256), UP_FLAG_TARGET = (NGU / 256) * NWAVES;
struct UpOrder {
    pg8::StaticOrder S; int G, c; unsigned* flag; LAS unsigned* lcnt;
    __device__ void init(int G_, int c_, unsigned* flag_, LAS unsigned* lcnt_) { S.init(MPR, NGU, G_, c_); G = G_; c = c_; flag = flag_; lcnt = lcnt_; }
    __device__ bool next(int i, Unit& u) const {
        const int L = i * G + c, NS = NGU / 256, head = G > NS ? G - NS : 0;
        if (L >= head && L < head + NS) { u.pm = 64; u.pn = L - head; return true; }
        return S.at(L < head ? L : L - NS, u);
    }
    __device__ __forceinline__ void a_ready(const Unit&) const {}
    __device__ __forceinline__ void done(const Unit& u) const {
        if (u.pm == 64) publish_unit(flag, lcnt);
    }
};
__device__ __forceinline__ bool skinny_early(int G) { const int rem = UP_UNITS % G; return MK_N_LAUNCHES == 1 && rem != 0 && G - rem >= 16; }

__device__ __forceinline__ int opaque_s(int x) { asm volatile("" : "+s"(x)); return x; }
__device__ __forceinline__ int hw_lane() { int l; asm volatile("v_mbcnt_lo_u32_b32 %0, -1, 0\n\tv_mbcnt_hi_u32_b32 %0, -1, %0" : "=v"(l)); return l; }
struct Frame {
    LAS unsigned char* lds;
    unsigned* ctl;
    int tid, lane, wave, G, gw, ngw;
    const void* const* in;
    float* out; unsigned char* ws;
};
#define WSP(T, off) ((T*)(F.ws + (off)))
#define FP(k) ((const float*)F.in[k])
#define FPI(k) ((const int*)F.in[k])

template <int K, bool F8 = false>
__device__ __forceinline__ void skinny_resid(Frame& F, const bf16* A_s, const bf16* Bt, int grp, const bf16* in_s  , float* out_s  , bf16* xb_s, float* rs_s, float scale, LAS float* part, unsigned char* x8_s = nullptr) {
    const int lane = F.lane, w = F.wave, c = lane & 31, hi = lane >> 5;
    constexpr int nks = K / 128;
    constexpr int NBATCH = nks > 11 ? 2 : 1, BS = nks / NBATCH;
    static_assert(nks % NBATCH == 0, "k-steps per wave split evenly into batches");
    const bf16* ap = A_s + (size_t)c * K + 16 * (w * nks) + 8 * hi;
    const bf16* bp = Bt + (size_t)(64 * grp + c) * K + 16 * (w * nks) + 8 * hi;
    u32x2 rbp[2][4];
#pragma unroll
    for (int tn = 0; tn < 2; ++tn)
#pragma unroll
        for (int g = 0; g < 4; ++g) rbp[tn][g] = w == 0 ? *(const u32x2*)(in_s + (size_t)c * D + 64 * grp + 32 * tn + 8 * g + 4 * hi) : (u32x2){0u, 0u};
    f32x16 acc[2];
#pragma unroll
    for (int tn = 0; tn < 2; ++tn)
#pragma unroll
        for (int i = 0; i < 16; ++i) acc[tn][i] = 0.f;
#pragma unroll
    for (int bi = 0; bi < NBATCH; ++bi) {
        if constexpr (F8) {
            const unsigned char* ap8 = (const unsigned char*)A_s + (size_t)c * K + 16 * (w * nks) + 8 * hi;
            const unsigned char* bp8 = (const unsigned char*)Bt + (size_t)(64 * grp + c) * K + 16 * (w * nks) + 8 * hi;
            long ta[BS], t0[BS], t1[BS];
#pragma unroll
            for (int i = 0; i < BS; ++i) { const int kk = bi * BS + i; ta[i] = *(const long*)(ap8 + 16 * kk); t0[i] = *(const long*)(bp8 + 16 * kk); t1[i] = *(const long*)(bp8 + (size_t)32 * K + 16 * kk); }
#pragma unroll
            for (int i = 0; i < BS; ++i) { acc[0] = __builtin_amdgcn_mfma_f32_32x32x16_fp8_fp8(t0[i], ta[i], acc[0], 0, 0, 0); acc[1] = __builtin_amdgcn_mfma_f32_32x32x16_fp8_fp8(t1[i], ta[i], acc[1], 0, 0, 0); }
        } else {
        bf16x8 ta[BS], t0[BS], t1[BS];
#pragma unroll
        for (int i = 0; i < BS; ++i) { const int kk = bi * BS + i; ta[i] = ld8(ap + 16 * kk); t0[i] = ld8(bp + 16 * kk); t1[i] = ld8(bp + (size_t)32 * K + 16 * kk); }
#pragma unroll
        for (int i = 0; i < BS; ++i) { acc[0] = mfma32(t0[i], ta[i], acc[0]); acc[1] = mfma32(t1[i], ta[i], acc[1]); }
        }
    }
#pragma unroll
    for (int tn = 0; tn < 2; ++tn)
#pragma unroll
        for (int r = 0; r < 16; ++r) part[((w * 2 + tn) * 16 + r) * 64 + lane] = acc[tn][r];
    __syncthreads();
    if (w == 0) {
        float ssq = 0.f;
        const size_t rowoff = (size_t)c * D;
#pragma unroll
        for (int tn = 0; tn < 2; ++tn)
#pragma unroll
            for (int g = 0; g < 4; ++g) {
                f32x4 v;
#pragma unroll
                for (int k = 0; k < 4; ++k) { float t = 0.f;
#pragma unroll
                    for (int ww = 0; ww < 8; ++ww) t += part[((ww * 2 + tn) * 16 + 4 * g + k) * 64 + lane];
                    v[k] = t; }
                const int col = 64 * grp + 32 * tn + 8 * g + 4 * hi;
                const u32x2 rb = rbp[tn][g];
                const f32x4 o = (f32x4){bf_lo(rb[0]), bf_hi(rb[0]), bf_lo(rb[1]), bf_hi(rb[1])} + v * scale;
                if (out_s) *(f32x4*)(out_s + rowoff + col) = o;
                if (xb_s) *(u32x2*)(xb_s + rowoff + col) = (u32x2){cvtpk(o[0], o[1]), cvtpk(o[2], o[3])};
                if (x8_s) *(unsigned*)(x8_s + rowoff + col) = cvtpk_fp8x4(o[0], o[1], o[2], o[3]);
                ssq += (o[0] * o[0] + o[1] * o[1]) + (o[2] * o[2] + o[3] * o[3]);
            }
        if (rs_s) { ssq = x32_sum(ssq); if (hi == 0) rs_s[(size_t)c * 16 + grp] = ssq; }
    }
    __syncthreads();
}

#ifdef DBG_NO_F8
#define F8W(w) 0
#else
#define F8W(w) (w)
#endif
#ifdef DBG_NO_F8D
#define F8D(w) 0
#else
#define F8D(w) (w)
#endif
struct TrDesc { const float* W; const float* gain; bf16* WTn0; int ldw, src0, nvalid, K, k0; int f8; };
__device__ __forceinline__ void tr_load(const TrDesc& d, float (&v)[32], int lane) {
#pragma unroll
    for (int i = 0; i < 32; ++i) {
        const int kk = 2 * i + (lane >> 5), j = lane & 31;
        float x = 0.f;
        if (j < d.nvalid) { x = d.W[(size_t)(d.k0 + kk) * d.ldw + d.src0 + j]; if (d.gain) x *= d.gain[d.k0 + kk]; }
        v[i] = x;
    }
}
__device__ __forceinline__ void tr_store(const TrDesc& d, const float (&v)[32], LAS float* scr, int lane) {
#pragma unroll
    for (int i = 0; i < 32; ++i) scr[(2 * i + (lane >> 5)) * 33 + (lane & 31)] = v[i];
    LDS_WAIT(); asm volatile("" ::: "memory");
    const int c = lane & 7;
#pragma unroll
    for (int jj = 0; jj < 4; ++jj) {
        const int n = (lane >> 3) + 8 * jj; const LAS float* s = scr + (8 * c) * 33 + n;
        if (d.f8) {
            *(u32x2*)((unsigned char*)d.WTn0 + (size_t)n * d.K + d.k0 + 8 * c) = (u32x2){cvtpk_fp8x4(s[0 * 33] * W8SCALE, s[1 * 33] * W8SCALE, s[2 * 33] * W8SCALE, s[3 * 33] * W8SCALE), cvtpk_fp8x4(s[4 * 33] * W8SCALE, s[5 * 33] * W8SCALE, s[6 * 33] * W8SCALE, s[7 * 33] * W8SCALE)};
        } else {
        u32x4 o; o.x = cvtpk(s[0 * 33], s[1 * 33]); o.y = cvtpk(s[2 * 33], s[3 * 33]); o.z = cvtpk(s[4 * 33], s[5 * 33]); o.w = cvtpk(s[6 * 33], s[7 * 33]);
        *(u32x4*)(d.WTn0 + (size_t)n * d.K + d.k0 + 8 * c) = o;
        }
    }
    LDS_WAIT(); asm volatile("" ::: "memory");
}
__device__ __forceinline__ void sincos_d(double a, float& c, float& s) {
    const double TWO_PI_HI = 6.283185307179586232, TWO_PI_LO = 2.449293598294706e-16, INV_2PI = 0.15915494309189534561;
    const double n = rint(a * INV_2PI);
    double r = fma(-n, TWO_PI_HI, a); r = fma(-n, TWO_PI_LO, r);
    const double r2 = r * r;
    double sn = 1.0, cs = 1.0, ts = 1.0, tc = 1.0;
#pragma unroll
    for (int k = 1; k <= 13; ++k) { tc *= -r2 * (1.0 / (double)((2 * k - 1) * (2 * k))); cs += tc; ts *= -r2 * (1.0 / (double)((2 * k) * (2 * k + 1))); sn += ts; }
    c = (float)cs; s = (float)(sn * r);
}
constexpr int TR_I_GU = 16 * (NGU / 32), TR_I_D = (FF / 64) * (D / 32), TR_I_IN = 16 * (NINX / 32), TR_I_OUT = 16 * (D / 32);
constexpr int TR_EARLY = TR_I_GU, TR_NITEMS = 2 * TR_I_GU + 2 * TR_I_D + TR_I_IN + TR_I_OUT;
__device__ __forceinline__ TrDesc tr_decode(Frame& F, int it) {
    constexpr int I_GU = TR_I_GU, I_D = TR_I_D, I_IN = TR_I_IN;
    int r = it;
    if (r < 2 * I_GU) {
        const int which = r / I_GU; r -= which * I_GU;
        const int nb = r % (NGU / 32), kb = r / (NGU / 32), n0 = nb * 32, p = n0 >> 8, rr = n0 & 255;
        const int src0 = rr < 128 ? 128 * p + rr : FF + 128 * p + (rr - 128);
        return TrDesc{which ? FP(24) : FP(11), which ? FP(23) : FP(10), F8W(which) ? (bf16*)(WSP(unsigned char, WS_WGU2) + (size_t)n0 * D) : WSP(bf16, which ? WS_WGU2 : WS_WGU1) + (size_t)n0 * D, NGU, src0, 32, D, kb * 64, F8W(which)};
    }
    r -= 2 * I_GU;
    if (r < 2 * I_D) {
        const int which = r / I_D; r -= which * I_D;
        const int nb = r % (D / 32), kb = r / (D / 32), n0 = nb * 32;
        return TrDesc{which ? FP(25) : FP(12), nullptr, F8D(which) ? (bf16*)(WSP(unsigned char, WS_WD2) + (size_t)n0 * FF) : WSP(bf16, which ? WS_WD2 : WS_WD1) + (size_t)n0 * FF, D, n0, 32, FF, kb * 64, F8D(which)};
    }
    r -= 2 * I_D;
    if (r < I_IN) {
        const int nb = r % (NINX / 32), kb = r / (NINX / 32), n0 = nb * 32, tile = n0 >> 8, tc = n0 & 255, bj = tc >> 7, wc = (tc & 127) >> 5;
        int src0 = 0, nvalid = 32; const float* W = FP(14); int ldw = 3400; const float* gain = FP(13);
        if (tile < 8) src0 = 256 * tile + 64 * wc + 32 * bj;
        else if (tile < 13) src0 = 2120 + 256 * (tile - 8) + 64 * wc + 32 * bj;
        else if (tile == 13) { if (wc == 0) src0 = 2048 + 32 * bj; else if (wc == 1 && bj == 0) { src0 = 2112; nvalid = 8; } else nvalid = 0; }
        else { W = FP(19); ldw = 512; gain = FP(18); src0 = (tile - 14) * 256 + 64 * wc + 32 * bj; }
        return TrDesc{W, gain, WSP(bf16, WS_WIN) + (size_t)n0 * D, ldw, src0, nvalid, D, kb * 64, 0};
    }
    r -= I_IN;
    { const int nb = r % (D / 32), kb = r / (D / 32), n0 = nb * 32;
      return TrDesc{FP(22), nullptr, WSP(bf16, WS_WOUT) + (size_t)n0 * D, D, n0, 32, D, kb * 64, 0}; }
}
__device__ __forceinline__ void weight_transposes(Frame& F, int it0, int it1, int w, int nw) {
    LAS float* scr = (LAS float*)(F.lds + F.wave * 16384);
    const int lane = F.lane;
    int it = it0 + w; if (it >= it1) return;
    float va[32], vb[32];
    TrDesc da = tr_decode(F, it), db = da;
    tr_load(da, va, lane);
    for (;;) {
        const int itb = it + nw; const bool hb = itb < it1;
        if (hb) { db = tr_decode(F, itb); tr_load(db, vb, lane); }
        tr_store(da, va, scr, lane);
        if (!hb) break;
        it = itb + nw; const bool ha = it < it1;
        if (ha) { da = tr_decode(F, it); tr_load(da, va, lane); }
        tr_store(db, vb, scr, lane);
        if (!ha) break;
    }
}
__device__ __forceinline__ int p1_idle_from(int G) { const int rem = (65 * (NGU / 256)) % G; return rem == 0 ? G : rem; }
__device__ __forceinline__ void p0_prologue(Frame& F) {
    const int lane = F.lane;
    weight_transposes(F, 0, TR_NITEMS, F.gw, F.ngw);
    bf16* XB = WSP(bf16, WS_XB); float* RS = WSP(float, WS_RS);
    for (int row0 = F.gw; row0 < XBROWS; row0 += 2 * F.ngw) {
        const float* srcs[2]; f32x4 v[2][4]; float ss[2];
#pragma unroll
        for (int u = 0; u < 2; ++u) { const int row = row0 + u * F.ngw;
            srcs[u] = row >= XBROWS ? nullptr : (row < MPR ? FP(0) + (size_t)row * D : (row < MPR + NSAMP ? FP(1) + (size_t)(row - MPR) * D : (row >= MP ? FP(2) + (size_t)(row - MP) * D : nullptr)));
#pragma unroll
            for (int j = 0; j < 4; ++j) v[u][j] = srcs[u] ? ((const f32x4*)srcs[u])[64 * j + lane] : (f32x4){0.f, 0.f, 0.f, 0.f}; }
#pragma unroll
        for (int u = 0; u < 2; ++u) { float t = 0.f;
#pragma unroll
            for (int j = 0; j < 4; ++j) t += (v[u][j].x * v[u][j].x + v[u][j].y * v[u][j].y) + (v[u][j].z * v[u][j].z + v[u][j].w * v[u][j].w);
            ss[u] = t; }
#pragma unroll
        for (int o = 1; o < 64; o <<= 1) { ss[0] += __shfl_xor(ss[0], o); ss[1] += __shfl_xor(ss[1], o); }
#pragma unroll
        for (int u = 0; u < 2; ++u) { const int row = row0 + u * F.ngw; if (row >= XBROWS) continue;
            float mul = 1.0f;
            if (row >= MP) mul = rsqrt_f(ss[u] * (1.0f / D) + EPS);
            u32x2* o8 = (u32x2*)(XB + (size_t)row * D);
#pragma unroll
            for (int j = 0; j < 4; ++j) o8[64 * j + lane] = (u32x2){cvtpk(v[u][j].x * mul, v[u][j].y * mul), cvtpk(v[u][j].z * mul, v[u][j].w * mul)};
            if (row < MP && lane < 16) RS[(size_t)row * 16 + lane] = lane == 0 ? ss[u] : 0.f;
            if (row >= MPR + NSAMP && row < MP) ((u32x4*)(WSP(unsigned char, WS_X1) + (size_t)row * D))[lane] = (u32x4){0u, 0u, 0u, 0u}; }
    }
    f32x2* rope = WSP(f32x2, WS_ROPE);
    for (int e = F.gw * 64 + lane; e < (PAST + 1) * 32; e += F.ngw * 64) {
        const int pos = e >> 5, j = e & 31;
        double inv = 1.0; for (int q = 0; q < j; ++q) inv *= 0.74989420933245582730;
        float c, s; sincos_d((double)pos * inv, c, s);
        rope[e] = (f32x2){c, s};
    }
}

__device__ __forceinline__ void idx_scores_item(int b, int qb, int kt_begin, int kt_end, const bf16* QI, const bf16* KI, const float* WI, unsigned* SC, int lane, LAS unsigned char* tl  ) {
    const int c = lane & 31, hi = lane >> 5;
    const size_t qrow0 = (size_t)b * SEQ + qb * 32, qrow = qrow0 + c;
    bf16x8 Bq[8][4];
#pragma unroll
    for (int h = 0; h < 8; ++h)
#pragma unroll
        for (int kk = 0; kk < 4; ++kk) Bq[h][kk] = ld8(QI + qrow * 512 + h * 64 + kk * 16 + hi * 8);
    const f32x4 w0 = *(const f32x4*)(WI + qrow * 8), w1 = *(const f32x4*)(WI + qrow * 8 + 4);
    const float wh[8] = {0.5f * w0[0], 0.5f * w0[1], 0.5f * w0[2], 0.5f * w0[3], 0.5f * w1[0], 0.5f * w1[1], 0.5f * w1[2], 0.5f * w1[3]};
    bf16x8 Bl[4];
#pragma unroll
    for (int kk = 0; kk < 4; ++kk) {
        float al[8] = {0.f, 0.f, 0.f, 0.f, 0.f, 0.f, 0.f, 0.f};
#pragma unroll
        for (int h = 0; h < 8; ++h) { const u32x4 q4 = __builtin_bit_cast(u32x4, Bq[h][kk]);
#pragma unroll
            for (int e = 0; e < 4; ++e) { al[2 * e] = fmaf(wh[h], bf_lo(q4[e]), al[2 * e]); al[2 * e + 1] = fmaf(wh[h], bf_hi(q4[e]), al[2 * e + 1]); } }
        const u32x4 pw = {cvtpk(al[0], al[1]), cvtpk(al[2], al[3]), cvtpk(al[4], al[5]), cvtpk(al[6], al[7])};
        Bl[kk] = __builtin_bit_cast(bf16x8, pw);
    }
    const f32x16 zero16 = {0.f, 0.f, 0.f, 0.f, 0.f, 0.f, 0.f, 0.f, 0.f, 0.f, 0.f, 0.f, 0.f, 0.f, 0.f, 0.f};
#define IDX_LOADK(A, kt_) do { const size_t krow_ = (size_t)b * SEQ + (size_t)(kt_) * 32 + c; _Pragma("unroll") for (int kk = 0; kk < 4; ++kk) A[kk] = ld8(KI + krow_ * 64 + kk * 16 + hi * 8); } while (0)
#define IDX_TILE(A, kt_) do { f32x16 sc; __builtin_amdgcn_s_setprio(1); sc = mfma32(A[0], Bl[0], zero16); _Pragma("unroll") for (int kk = 1; kk < 4; ++kk) sc = mfma32(A[kk], Bl[kk], sc); __builtin_amdgcn_s_setprio(0); \
        _Pragma("unroll") for (int h = 0; h < 8; ++h) { f32x16 a; __builtin_amdgcn_s_setprio(1); a = mfma32(A[0], Bq[h][0], zero16); _Pragma("unroll") for (int kk = 1; kk < 4; ++kk) a = mfma32(A[kk], Bq[h][kk], a); __builtin_amdgcn_s_setprio(0); \
            sc[0] = __builtin_fmaf(wh[h], __builtin_fabsf(a[0]), sc[0]);     \
            _Pragma("unroll") for (int i = 1; i < 16; ++i) asm volatile("v_fma_f32 %0, %1, |%2|, %0" : "+v"(sc[i]) : "v"(wh[h]), "v"(a[i]), "v"(sc[0])); \
            __builtin_amdgcn_sched_barrier(0); } \
        unsigned ky[16]; _Pragma("unroll") for (int i = 0; i < 16; ++i) { const unsigned u_ = __float_as_uint(sc[i]); ky[i] = u_ ^ ((unsigned)((int)u_ >> 31) | 0x80000000u); } \
        _Pragma("unroll") for (int g = 0; g < 4; ++g) *(LAS u32x4*)(tl + c * 144 + g * 32 + hi * 16) = (u32x4){ky[4 * g], ky[4 * g + 1], ky[4 * g + 2], ky[4 * g + 3]}; \
        asm volatile("s_waitcnt lgkmcnt(0)" ::: "memory"); \
        { unsigned* dstp = SC + (qrow0 + (lane >> 3)) * SEQ + (size_t)(kt_) * 32 + (lane & 7) * 4; \
          _Pragma("unroll") for (int i = 0; i < 4; ++i) *(u32x4*)(dstp + (size_t)(8 * i) * SEQ) = *(const LAS u32x4*)(tl + (8 * i + (lane >> 3)) * 144 + (lane & 7) * 16); } \
        asm volatile("s_waitcnt lgkmcnt(0)" ::: "memory"); } while (0)
    bf16x8 A0[4], A1[4];
    const int kt0 = kt_begin, ktl = kt_end - 1;
    IDX_LOADK(A0, kt0);
#pragma unroll 1
    for (int kt = kt0; kt < kt_end; kt += 2) {
        IDX_LOADK(A1, (kt + 1 < ktl ? kt + 1 : ktl));
        IDX_TILE(A0, kt);
        if (kt + 1 < kt_end) {
            IDX_LOADK(A0, (kt + 2 < ktl ? kt + 2 : ktl));
            IDX_TILE(A1, kt + 1);
        }
    }
#undef IDX_LOADK
#undef IDX_TILE
}
__device__ __forceinline__ void sample_scores_item(Frame& F, int b, int page, LAS float* qs  , int kq0 = 0, int kq1 = 2, bool reuse_q = false) {
    const int lane = F.lane; const size_t row = MPR + b;
    const int phys = page < NPAGES ? FPI(9)[b * NPAGES + page] : 0;
    const bf16* QI = WSP(bf16, WS_QI) + row * 512; const float* WI = WSP(float, WS_WI) + row * 8;
    if (!reuse_q) {
#pragma unroll
        for (int j = 0; j < 8; ++j) qs[64 * j + lane] = bf2f(QI[64 * j + lane]);
        if (lane < 8) qs[512 + lane] = WI[lane];
    }
    LDS_WAIT(); asm volatile("" ::: "memory");
    float* SSC = WSP(float, WS_SSC) + (size_t)b * SSC_LD;
    const int nk = page < NPAGES ? 2 : 1;
    for (int kq = kq0; kq < nk && kq < kq1; ++kq) {
        const float* kp; bool active = true; int kidx;
        if (page < NPAGES) { const int key = lane + 64 * kq; kp = FP(5) + ((size_t)phys * PAGE + key) * 64; kidx = page * PAGE + key; }
        else { kp = F.out + O_KIS + (size_t)b * 64; active = lane == 0; kidx = PAST; }
        float a[8] = {0.f, 0.f, 0.f, 0.f, 0.f, 0.f, 0.f, 0.f};
        if (active) {
#pragma unroll 8
            for (int d4 = 0; d4 < 16; ++d4) {
                const f32x4 kv = *(const f32x4*)(kp + 4 * d4);
#pragma unroll
                for (int h = 0; h < 8; ++h) { const f32x4 q = *(const LAS f32x4*)(qs + 64 * h + 4 * d4); a[h] = fmaf(kv[0], q[0], fmaf(kv[1], q[1], fmaf(kv[2], q[2], fmaf(kv[3], q[3], a[h])))); }
            }
            float s = 0.f;
#pragma unroll
            for (int h = 0; h < 8; ++h) s = fmaf(qs[512 + h], fmaxf(a[h], 0.f), s);
            SSC[kidx] = s;
        }
    }
    LDS_WAIT(); asm volatile("" ::: "memory");
}
__device__ __forceinline__ void ret_kv_item(Frame& F, int item) {
    const int lane = F.lane, c = lane & 31, hi = lane >> 5;
    const int tk = item & 1, tv = (item >> 1) & 1, ch = (item >> 2) & 63, bh = item >> 8;
    const bf16* A = WSP(bf16, WS_RVT) + ((size_t)bh * 64 + 32 * tv + c) * SEQ + 128 * ch + 8 * hi;
    const bf16* B = WSP(bf16, WS_RKDT) + ((size_t)bh * 64 + 32 * tk + c) * SEQ + 128 * ch + 8 * hi;
    f32x16 acc;
#pragma unroll
    for (int i = 0; i < 16; ++i) acc[i] = 0.f;
#pragma unroll
    for (int kk = 0; kk < 8; ++kk) acc = mfma32(ld8(A + 16 * kk), ld8(B + 16 * kk), acc);
    float* dst = WSP(float, WS_KVS) + ((size_t)bh * 64 + ch) * 4096 + 32 * tk + c;
#pragma unroll
    for (int r = 0; r < 16; ++r) dst[(size_t)(32 * tv + 8 * (r >> 2) + 4 * hi + (r & 3)) * 64] = acc[r];
}
constexpr int MA_KP = 144, MA_VP = 528, MA_KBYTES = 256 * MA_KP, MA_VBYTES = 64 * MA_VP;
__device__ __forceinline__ void mem_attn_wg(Frame& F, int item) {
    const int lane = F.lane, tid = F.tid, c = lane & 31, hi = lane >> 5;
    const int ig = item & 31, h = (item >> 5) & 3, b = item >> 7, it = 8 * ig + F.wave;
    {
        const bf16* MKg = WSP(bf16, WS_MK) + (size_t)(b * 4 + h) * 256 * 64; const bf16* MVg = WSP(bf16, WS_MVT) + (size_t)(b * 4 + h) * 64 * 256;
#pragma unroll
        for (int q = 0; q < 4; ++q) { const int e = tid + 512 * q, r = e >> 3, pc = e & 7; *(LAS u32x4*)(F.lds + r * MA_KP + 16 * pc) = *(const u32x4*)(MKg + r * 64 + 8 * pc); }
#pragma unroll
        for (int q = 0; q < 4; ++q) { const int e = tid + 512 * q, r = e >> 5, pc = e & 31; *(LAS u32x4*)(F.lds + MA_KBYTES + r * MA_VP + 16 * pc) = *(const u32x4*)(MVg + r * 256 + 8 * pc); }
    }
    const size_t row = (size_t)b * SEQ + it * 32 + c;
    const bf16* MQ = WSP(bf16, WS_MQ) + row * 256 + 64 * h + 8 * hi;
    bf16x8 Bq[4];
#pragma unroll
    for (int kk = 0; kk < 4; ++kk) Bq[kk] = ld8(MQ + 16 * kk);
    __syncthreads();
    const LAS unsigned char* kr = F.lds + c * MA_KP + 16 * hi; const LAS unsigned char* vr = F.lds + MA_KBYTES + c * MA_VP + 16 * hi;
    f32x16 o[2];
#pragma unroll
    for (int tv = 0; tv < 2; ++tv)
#pragma unroll
        for (int i = 0; i < 16; ++i) o[tv][i] = 0.f;
    const float sc = 0.125f * LOG2E; float sum = 0.f, mx = -INFINITY;
#pragma unroll 2
    for (int T = 0; T < 8; ++T) {
        f32x16 st;
#pragma unroll
        for (int i = 0; i < 16; ++i) st[i] = 0.f;
#pragma unroll
        for (int kk = 0; kk < 4; ++kk) st = mfma32(*(const LAS bf16x8*)(kr + T * 32 * MA_KP + 32 * kk), Bq[kk], st);
        float tm = st[0];
#pragma unroll
        for (int i = 1; i < 16; ++i) tm = fmaxf(tm, st[i]);
        tm = x32_max(tm);
        const float mn = fmaxf(mx, tm), alpha = fast_exp2((mx - mn) * sc);
        mx = mn; sum *= alpha;
#pragma unroll
        for (int tv = 0; tv < 2; ++tv)
#pragma unroll
            for (int i = 0; i < 16; ++i) o[tv][i] *= alpha;
        float ps = 0.f;
#pragma unroll
        for (int i = 0; i < 16; ++i) { const float p = fast_exp2((st[i] - mn) * sc); st[i] = p; ps += p; }
        sum += x32_sum(ps);
#pragma unroll
        for (int s2 = 0; s2 < 2; ++s2) {
            const u32x4 pw = {cvtpk(st[8 * s2], st[8 * s2 + 1]), cvtpk(st[8 * s2 + 2], st[8 * s2 + 3]), cvtpk(st[8 * s2 + 4], st[8 * s2 + 5]), cvtpk(st[8 * s2 + 6], st[8 * s2 + 7])};
            const bf16x8 pb = __builtin_bit_cast(bf16x8, pw);
#pragma unroll
            for (int tv = 0; tv < 2; ++tv) o[tv] = mfma32(*(const LAS bf16x8*)(vr + tv * 32 * MA_VP + 64 * T + 32 * s2), pb, o[tv]);
        }
    }
    const float inv = 1.0f / sum;
    bf16* CAT = WSP(bf16, WS_CAT) + row * D + 768 + 64 * h;
#pragma unroll
    for (int tv = 0; tv < 2; ++tv)
#pragma unroll
        for (int g = 0; g < 4; ++g)
            *(u32x2*)(CAT + 32 * tv + 8 * g + 4 * hi) = (u32x2){cvtpk(o[tv][4 * g] * inv, o[tv][4 * g + 1] * inv), cvtpk(o[tv][4 * g + 2] * inv, o[tv][4 * g + 3] * inv)};
    __syncthreads();
}
__device__ __forceinline__ void sample_ret_item(Frame& F, int item) {
    const int lane = F.lane, h = item & 3, b = item >> 2; const size_t row = MPR + b;
    const float kreg = bf2f(WSP(bf16, WS_RK)[row * 256 + 64 * h + lane]), qreg = bf2f(WSP(bf16, WS_RQ)[row * 256 + 64 * h + lane]), v = bf2f(WSP(bf16, WS_RV)[row * 256 + 64 * h + lane]);
    const float gam = 1.0f - exp2f(-5.0f - (float)h);
    const float* S = FP(6) + ((size_t)(b * 4 + h) * 64) * 64 + lane; float* So = F.out + O_RETS + ((size_t)(b * 4 + h) * 64) * 64 + lane;
    float o = 0.f;
    float sv[64];
#pragma unroll
    for (int dk = 0; dk < 64; ++dk) sv[dk] = S[(size_t)dk * 64];
#pragma unroll
    for (int dk = 0; dk < 64; ++dk) {
        const float kk = __shfl(kreg, dk), qq = __shfl(qreg, dk);
        const float sn = fmaf(gam, sv[dk], kk * v);
        So[(size_t)dk * 64] = sn; o = fmaf(qq, sn, o);
    }
    const float ssq = wave_sum(o * o);
    const float rn = rsqrt_f(ssq * (1.0f / 64.0f) + EPS);
    const float y = o * rn * FP(17)[64 * h + lane] * bf2f(WSP(bf16, WS_SG)[row * 256 + 64 * h + lane]);
    WSP(bf16, WS_CAT)[row * D + 512 + 64 * h + lane] = f2bf(y);
}
__device__ __forceinline__ void p5_scan(Frame& F) {
    const float* KVS = WSP(float, WS_KVS); bf16* SB = WSP(bf16, WS_SB);
    for (int e = blockIdx.x * 512 + F.tid; e < 8 * 4096; e += F.G * 512) {
        const int bh = e >> 12, r = e & 4095, h = bh & 3;
        const float g128 = exp2f(128.0f * log2_gamma(h));
        float S = 0.f; float kvv[64];
#pragma unroll
        for (int ch = 0; ch < 64; ++ch) kvv[ch] = KVS[((size_t)bh * 64 + ch) * 4096 + r];
#pragma unroll
        for (int ch = 0; ch < 64; ++ch) { SB[((size_t)bh * 64 + ch) * 4096 + r] = f2bf(S); S = fmaf(g128, S, kvv[ch]); }
        F.out[O_RETP + (size_t)bh * 4096 + (r & 63) * 64 + (r >> 6)] = S;
    }
}

__device__ __forceinline__ void ret_out_item(Frame& F, int item) {
    const int lane = F.lane, c = lane & 31, hi = lane >> 5;
    const int it = item & 3, ch = (item >> 2) & 63, bh = item >> 8, h = bh & 3, b = bh >> 2;
    const size_t tok0 = (size_t)b * SEQ + 128 * ch;
    const float lg = log2_gamma(h);
    const bf16* RQ = WSP(bf16, WS_RQ) + (tok0 + 32 * it + c) * 256 + 64 * h + 8 * hi;
    bf16x8 Bq[4];
#pragma unroll
    for (int kk = 0; kk < 4; ++kk) Bq[kk] = ld8(RQ + 16 * kk);
    f32x16 o[2];
#pragma unroll
    for (int tv = 0; tv < 2; ++tv)
#pragma unroll
        for (int i = 0; i < 16; ++i) o[tv][i] = 0.f;
    const int itu = __builtin_amdgcn_readfirstlane(it);
    const bf16* SBu = WSP(bf16, WS_SB) + ((size_t)bh * 64 + ch) * 64 * 64;
    const bf16* RKu = WSP(bf16, WS_RK) + tok0 * 256 + 64 * h;
    const bf16* RVTu = WSP(bf16, WS_RVT) + (size_t)bh * 64 * SEQ + 128 * ch;
    const unsigned sbo = (unsigned)(c * 64 + 8 * hi) * 2u, rko = (unsigned)(c * 256 + 8 * hi) * 2u, rvo = (unsigned)(c * SEQ + 8 * hi) * 2u;
#define LD8U(ubase, voff) (*(const bf16x8*)((const char*)(ubase) + (voff)))
    const bf16x8 zero8 = {0, 0, 0, 0, 0, 0, 0, 0};
    bf16x8 sbf[2][4], kf[4][4], vf[4][2][2];
#pragma unroll
    for (int tv = 0; tv < 2; ++tv)
#pragma unroll
        for (int kk = 0; kk < 4; ++kk) sbf[tv][kk] = LD8U(SBu + (size_t)tv * 32 * 64 + 16 * kk, sbo);
#pragma unroll
    for (int jt = 0; jt < 4; ++jt) {
        if (jt <= itu) {
#pragma unroll
            for (int kk = 0; kk < 4; ++kk) kf[jt][kk] = LD8U(RKu + (size_t)jt * 32 * 256 + 16 * kk, rko);
        } else {
#pragma unroll
            for (int kk = 0; kk < 4; ++kk) kf[jt][kk] = zero8;
        }
    }
#define RO_LOADV(jt) do { if ((jt) <= itu) { _Pragma("unroll") for (int s2 = 0; s2 < 2; ++s2) _Pragma("unroll") for (int tv = 0; tv < 2; ++tv) vf[jt][s2][tv] = LD8U(RVTu + (size_t)tv * 32 * SEQ + 32 * (jt) + 16 * s2, rvo); } \
        else { _Pragma("unroll") for (int s2 = 0; s2 < 2; ++s2) _Pragma("unroll") for (int tv = 0; tv < 2; ++tv) vf[jt][s2][tv] = zero8; } } while (0)
    RO_LOADV(0); RO_LOADV(1);
    asm volatile("" ::: "memory");
#pragma unroll
    for (int tv = 0; tv < 2; ++tv)
#pragma unroll
        for (int kk = 0; kk < 4; ++kk) o[tv] = mfma32(sbf[tv][kk], Bq[kk], o[tv]);
    asm volatile("" ::: "memory");
    RO_LOADV(2); RO_LOADV(3);
    const size_t row = tok0 + 32 * it + c;
    const bf16* SG = WSP(bf16, WS_SG) + row * 256 + 64 * h;
    u32x2 sgp[2][4];
#pragma unroll
    for (int tv = 0; tv < 2; ++tv)
#pragma unroll
        for (int g = 0; g < 4; ++g) sgp[tv][g] = *(const u32x2*)(SG + 32 * tv + 8 * g + 4 * hi);
    asm volatile("" ::: "memory");
#undef RO_LOADV
#undef LD8U
    const int i_abs = 32 * it + c;
    { const float qd = fast_exp2((float)(i_abs + 1) * lg);
#pragma unroll
      for (int tv = 0; tv < 2; ++tv)
#pragma unroll
          for (int i = 0; i < 16; ++i) o[tv][i] *= qd; }
#pragma unroll
    for (int jt = 0; jt < 4; ++jt) {
        if (jt <= itu) {
            f32x16 st;
#pragma unroll
            for (int i = 0; i < 16; ++i) st[i] = 0.f;
#pragma unroll
            for (int kk = 0; kk < 4; ++kk) st = mfma32(kf[jt][kk], Bq[kk], st);
            int jo = 32 * jt; asm volatile("" : "+s"(jo));
#pragma unroll
            for (int r = 0; r < 16; ++r) { const int j_abs = jo + 8 * (r >> 2) + 4 * hi + (r & 3); const int df = i_abs - j_abs; st[r] = df >= 0 ? st[r] * fast_exp2((float)df * lg) : 0.f; }
#pragma unroll
            for (int s2 = 0; s2 < 2; ++s2) {
                const u32x4 pw = {cvtpk(st[8 * s2], st[8 * s2 + 1]), cvtpk(st[8 * s2 + 2], st[8 * s2 + 3]), cvtpk(st[8 * s2 + 4], st[8 * s2 + 5]), cvtpk(st[8 * s2 + 6], st[8 * s2 + 7])};
                const bf16x8 pb = __builtin_bit_cast(bf16x8, pw);
#pragma unroll
                for (int tv = 0; tv < 2; ++tv) o[tv] = mfma32(vf[jt][s2][tv], pb, o[tv]);
            }
        }
    }
    float ssq = 0.f;
#pragma unroll
    for (int tv = 0; tv < 2; ++tv)
#pragma unroll
        for (int i = 0; i < 16; ++i) ssq += o[tv][i] * o[tv][i];
    ssq = x32_sum(ssq);
#ifdef DBG_ZERO_RET
    const float rn = 0.f;
#else
    const float rn = rsqrt_f(ssq * (1.0f / 64.0f) + EPS);
#endif
    bf16* CAT = WSP(bf16, WS_CAT) + row * D + 512 + 64 * h;
#pragma unroll
    for (int tv = 0; tv < 2; ++tv)
#pragma unroll
        for (int g = 0; g < 4; ++g) {
            const int dv = 32 * tv + 8 * g + 4 * hi;
            const f32x4 gn = *(const f32x4*)(FP(17) + 64 * h + dv); const u32x2 sg = sgp[tv][g];
            const float y0 = o[tv][4 * g] * rn * gn[0] * bf_lo(sg.x), y1 = o[tv][4 * g + 1] * rn * gn[1] * bf_hi(sg.x), y2 = o[tv][4 * g + 2] * rn * gn[2] * bf_lo(sg.y), y3 = o[tv][4 * g + 3] * rn * gn[3] * bf_hi(sg.y);
            *(u32x2*)(CAT + dv) = (u32x2){cvtpk(y0, y1), cvtpk(y2, y3)};
        }
}

__device__ __forceinline__ unsigned f2ord(float f) { const unsigned u = __float_as_uint(f); return (u & 0x80000000u) ? ~u : (u | 0x80000000u); }
template <int NBLK, bool BITS, typename TIn>
__device__ __forceinline__ int select_topk(const TIn* __restrict__ row, const int n_valid_, LAS unsigned* hist, LAS unsigned short* list, unsigned long long* mout, const int lane, const TIn* pf_row = nullptr, int pf_n = 0) {
    constexpr int NJ = 8 * NBLK;
    const int n_valid = __builtin_amdgcn_readfirstlane(n_valid_);
    if (n_valid <= 256) {
        if (BITS) { if (lane < 4) { const int nbits = n_valid - 64 * lane; mout[lane] = nbits >= 64 ? ~0ull : (nbits > 0 ? ((1ull << nbits) - 1ull) : 0ull); } return n_valid; }
        for (int k = lane; k < ((n_valid + 15) & ~15); k += 64) list[k] = (unsigned short)(k < n_valid ? k : 0); LDS_WAIT(); asm volatile("" ::: "memory"); return n_valid;
    }
    const int njv = (n_valid + 63) >> 6;
    int ln = lane; asm volatile("" : "+v"(ln));
    const TIn* rowl = row + ln;
    unsigned key[NJ];
#pragma unroll
    for (int qd = 0; qd < 4; ++qd) {
        constexpr int QB = (NBLK + 3) / 4;
        if (8 * QB * qd < njv) {
#pragma unroll
            for (int bk = QB * qd; bk < QB * (qd + 1) && bk < NBLK; ++bk)
#pragma unroll
                for (int jj = 0; jj < 8; ++jj) { if constexpr (__is_same(TIn, float)) key[8 * bk + jj] = __float_as_uint(rowl[64 * (8 * bk + jj)]); else key[8 * bk + jj] = (unsigned)rowl[64 * (8 * bk + jj)]; }
        } else {
#pragma unroll
            for (int bk = QB * qd; bk < QB * (qd + 1) && bk < NBLK; ++bk)
#pragma unroll
                for (int jj = 0; jj < 8; ++jj) key[8 * bk + jj] = 0u;
        }
    }
#pragma unroll
    for (int bk = 0; bk < NBLK; ++bk) {
        if constexpr (__is_same(TIn, float)) {
#pragma unroll
            for (int jj = 0; jj < 8; ++jj) { const unsigned u = key[8 * bk + jj]; key[8 * bk + jj] = u ^ ((unsigned)((int)u >> 31) | 0x80000000u); }
        }
        if (8 * bk + 8 > (n_valid >> 6)) {
#pragma unroll
            for (int jj = 0; jj < 8; ++jj) { const int j = 8 * bk + jj; key[j] = (ln < n_valid - 64 * j) ? key[j] : 0u; }
        }
    }
    unsigned pfx = 0u;
    if (pf_row) {
#pragma unroll
        for (int i = 0; i < 4; ++i) { const int e = ln * 32 + i * 2048; if (e < pf_n) pfx ^= __builtin_bit_cast(unsigned, pf_row[e]); }
    }
    unsigned g0 = 0u, g1 = 0u, g2 = 0u, g3 = 0u;
#pragma unroll
    for (int j = 0; j < NJ; ++j) { const unsigned k = key[j]; if ((j & 3) == 0) g0 = g0 > k ? g0 : k; else if ((j & 3) == 1) g1 = g1 > k ? g1 : k; else if ((j & 3) == 2) g2 = g2 > k ? g2 : k; else g3 = g3 > k ? g3 : k; }
    unsigned mx = g0 > g1 ? g0 : g1; { const unsigned t = g2 > g3 ? g2 : g3; mx = mx > t ? mx : t; }
    unsigned lb = g0 < g1 ? g0 : g1; { const unsigned t = g2 < g3 ? g2 : g3; lb = lb < t ? lb : t; }
    mx = wave_max_u_dpp(mx); lb = wave_min_u_dpp(lb);
    unsigned lo = lb > 1u ? lb : 1u, hi = mx; int need = 256; bool all_in = false;
    for (int iter = 0; iter < 8; ++iter) {
        const unsigned width = hi - lo;
        const int shift = width >= 256u ? (24 - __builtin_clz(width)) : 0;
        hist[lane] = 0u; hist[lane + 64] = 0u; hist[lane + 128] = 0u; hist[lane + 192] = 0u;
        LDS_WAIT(); asm volatile("" ::: "memory");
#pragma unroll
        for (int bk = 0; bk < NBLK; ++bk) {
            if (8 * bk < njv) {
#pragma unroll
                for (int jj = 0; jj < 8; ++jj) { const unsigned dk = key[8 * bk + jj] - lo;
                    const unsigned bin = dk <= width ? (dk >> shift) : 256u + (unsigned)ln; __hip_atomic_fetch_add(hist + bin, 1u, __ATOMIC_RELAXED, __HIP_MEMORY_SCOPE_WAVEFRONT);
#ifdef DBG_DOUBLE_ATOMIC
                    __hip_atomic_fetch_add(hist + 256u + (unsigned)ln, 1u, __ATOMIC_RELAXED, __HIP_MEMORY_SCOPE_WAVEFRONT);
#endif
                    }
            }
            __builtin_amdgcn_sched_barrier(0);
        }
        LDS_WAIT(); asm volatile("" ::: "memory");
        const u32x4 cc = *(const LAS u32x4*)(hist + 4 * lane);
        const unsigned s = (cc.x + cc.y) + (cc.z + cc.w);
        const unsigned pre = wave_prefix_sum_dpp(s);
        const unsigned tot = (unsigned)__builtin_amdgcn_readlane((int)pre, 63);
        const unsigned a3 = tot - pre, a2 = a3 + cc.w, a1 = a2 + cc.z, a0 = a1 + cc.y;
        const unsigned nd = (unsigned)need;
        int myi = -1; unsigned myab = 0u, mycnt = 0u;
        if (a3 < nd && nd <= a3 + cc.w) { myi = 3; myab = a3; mycnt = cc.w; }
        else if (a2 < nd && nd <= a2 + cc.z) { myi = 2; myab = a2; mycnt = cc.z; }
        else if (a1 < nd && nd <= a1 + cc.y) { myi = 1; myab = a1; mycnt = cc.y; }
        else if (a0 < nd && nd <= a0 + cc.x) { myi = 0; myab = a0; mycnt = cc.x; }
        const unsigned long long bm = __ballot(myi >= 0);
        if (bm == 0ull) break;
        const int owner = __builtin_amdgcn_readfirstlane(__builtin_ctzll(bm));
        const int B = 4 * owner + __builtin_amdgcn_readlane(myi, owner); const unsigned above = (unsigned)__builtin_amdgcn_readlane((int)myab, owner), nin = (unsigned)__builtin_amdgcn_readlane((int)mycnt, owner);
        need -= (int)above;
        const unsigned lo_n = lo + ((unsigned)B << shift);
        unsigned hi_n = lo_n + ((1u << shift) - 1u); if (hi_n > hi || hi_n < lo_n) hi_n = hi;
        lo = lo_n; hi = hi_n;
        if (shift == 0 || nin == (unsigned)need) { all_in = nin == (unsigned)need; break; }
    }
    int base = 0, ties = 0;
    unsigned wl[(NBLK + 7) / 8], wh[(NBLK + 7) / 8];
#pragma unroll
    for (int q = 0; q < (NBLK + 7) / 8; ++q) { wl[q] = 0u; wh[q] = 0u; }
    if (BITS && all_in) {
#pragma unroll
        for (int bk = 0; bk < NBLK; ++bk) {
            if (8 * bk < njv) {
#pragma unroll
                for (int jj = 0; jj < 8; ++jj) {
                    const int j = 8 * bk + jj;
                    const unsigned long long m_sel = __ballot(key[j] >= lo);
                    const unsigned mlo = (unsigned)m_sel, mhi = (unsigned)(m_sel >> 32);
                    asm volatile("s_nop 1\n\tv_writelane_b32 %0, %2, %4\n\tv_writelane_b32 %1, %3, %4" : "+v"(wl[j >> 6]), "+v"(wh[j >> 6]) : "s"(mlo), "s"(mhi), "i"(j & 63));
                }
            }
            __builtin_amdgcn_sched_barrier(0);
        }
    } else
#pragma unroll
    for (int bk = 0; bk < NBLK; ++bk) {
        if (8 * bk < njv) {
#pragma unroll
            for (int jj = 0; jj < 8; ++jj) {
                const int j = 8 * bk + jj; const unsigned k = key[j];
                const bool inb = (k >= lo) && (k <= hi);
                const unsigned long long m_in = __ballot(inb);
                const bool sel = (k > hi) || (inb && (ties + mbcnt64(m_in) < need));
                const unsigned long long m_sel = __ballot(sel);
                if (BITS) { const unsigned mlo = (unsigned)m_sel, mhi = (unsigned)(m_sel >> 32);
                    asm volatile("s_nop 1\n\tv_writelane_b32 %0, %2, %4\n\tv_writelane_b32 %1, %3, %4" : "+v"(wl[j >> 6]), "+v"(wh[j >> 6]) : "s"(mlo), "s"(mhi), "i"(j & 63)); }
                else if (sel) { const int pos = base + mbcnt64(m_sel); if (pos < 256) list[pos] = (unsigned short)(64 * j + ln); }
                base += __builtin_popcountll(m_sel); ties += __builtin_popcountll(m_in);
            }
        }
        __builtin_amdgcn_sched_barrier(0);
    }
    if (BITS) {
#pragma unroll
        for (int q = 0; q < (NBLK + 7) / 8; ++q) if (64 * q + ln < njv) mout[64 * q + ln] = ((unsigned long long)wh[q] << 32) | wl[q];
    }
    if (pf_row && pfx == 0x9e3779b9u) hist[256 + ln] = pfx;
    LDS_WAIT(); asm volatile("" ::: "memory");
    return base < 256 ? base : 256;
}

constexpr int AT_PITCH = 144, AT_KBYTES = 64 * AT_PITCH, AT_STAGE = 2 * AT_KBYTES, AT_NSTAGE = 3;
template <bool FIXED>
__device__ __forceinline__ void attn_dense_item(Frame& F, int b, int h, int qb, bf16* cat_base, float mfix) {
    const int tid = F.tid, lane = F.lane, w = F.wave, c = lane & 31, hi = lane >> 5;
    const int qt = 8 * qb + w;
    const size_t qrow = (size_t)b * SEQ + 32 * qt + c;
    bf16x8 Bq[4];
#pragma unroll
    for (int kk = 0; kk < 4; ++kk) Bq[kk] = ld8(WSP(bf16, WS_Q) + qrow * 512 + 64 * h + 16 * kk + 8 * hi);
    const unsigned long long* mrow = WSP(unsigned long long, WS_MASK) + qrow * 128;
    const int nt = 4 * qb + 4;
    const int sr = tid >> 3, spc = tid & 7;
    const bf16* ksrc = WSP(bf16, WS_K) + ((size_t)b * SEQ + sr) * 512 + 64 * h + 8 * spc;
    const bf16* vsrc = WSP(bf16, WS_VTA) + ((size_t)(b * 8 + h) * 64 + sr) * SEQ + 8 * spc;
    LAS unsigned char* sdst = F.lds + sr * AT_PITCH + 16 * spc;
    u32x4 kreg = *(const u32x4*)ksrc, vreg = *(const u32x4*)vsrc;
    *(LAS u32x4*)sdst = kreg; *(LAS u32x4*)(sdst + AT_KBYTES) = vreg;
    { const int t1 = nt > 1 ? 1 : 0; kreg = *(const u32x4*)(ksrc + (size_t)t1 * 64 * 512); vreg = *(const u32x4*)(vsrc + t1 * 64); }
    unsigned long long mw = mrow[0];
    f32x16 o[2];
#pragma unroll
    for (int tv = 0; tv < 2; ++tv)
#pragma unroll
        for (int i = 0; i < 16; ++i) o[tv][i] = 0.f;
    float m = -INFINITY, l = 0.f;
    const float sc = 1.0f;
    const LAS unsigned char* kread = F.lds + c * AT_PITCH + 16 * hi;
    const LAS unsigned char* vread = F.lds + AT_KBYTES + c * AT_PITCH + 16 * hi;
#define AT_QK(sd_, stg_, u_) do { _Pragma("unroll") for (int i = 0; i < 16; ++i) sd_[i] = 0.f; __builtin_amdgcn_s_setprio(1); \
        _Pragma("unroll") for (int kk = 0; kk < 4; ++kk) sd_ = mfma32(*(const LAS bf16x8*)(kread + (stg_) + 32 * (u_) * AT_PITCH + 32 * kk), Bq[kk], sd_); __builtin_amdgcn_s_setprio(0); } while (0)
#define AT_SMPV(sd_, w32_, stg_, u_) do { float mc; \
        if (FIXED) mc = 0.f; \
        else { float tm = fmaxf(fmaxf(fmaxf(sd_[0], sd_[1]), fmaxf(sd_[2], sd_[3])), fmaxf(fmaxf(sd_[4], sd_[5]), fmaxf(sd_[6], sd_[7]))); \
            tm = fmaxf(tm, fmaxf(fmaxf(fmaxf(sd_[8], sd_[9]), fmaxf(sd_[10], sd_[11])), fmaxf(fmaxf(sd_[12], sd_[13]), fmaxf(sd_[14], sd_[15])))); \
            tm = x32_max(tm); const float mn = fmaxf(m, tm), alpha = fast_exp2((m - mn) * sc); mc = mn * sc; m = mn; l *= alpha; \
            _Pragma("unroll") for (int tv = 0; tv < 2; ++tv) _Pragma("unroll") for (int i = 0; i < 16; ++i) o[tv][i] *= alpha; } \
        const unsigned Wh = (unsigned)(w32_) >> (4 * hi); float ps = 0.f; \
        _Pragma("unroll") for (int r = 0; r < 16; ++r) { const float p = FIXED ? fast_exp2(sd_[r]) : fast_exp2(sd_[r] - mc); \
            const float pm = __uint_as_float(__float_as_uint(p) & (unsigned)__builtin_amdgcn_sbfe((int)Wh, 8 * (r >> 2) + (r & 3), 1)); ps += pm; sd_[r] = pm; } \
        l += ps; __builtin_amdgcn_s_setprio(1); \
        _Pragma("unroll") for (int s2 = 0; s2 < 2; ++s2) { \
            const u32x4 pw = {cvtpk(sd_[8 * s2], sd_[8 * s2 + 1]), cvtpk(sd_[8 * s2 + 2], sd_[8 * s2 + 3]), cvtpk(sd_[8 * s2 + 4], sd_[8 * s2 + 5]), cvtpk(sd_[8 * s2 + 6], sd_[8 * s2 + 7])}; \
            const bf16x8 pb = __builtin_bit_cast(bf16x8, pw); \
            _Pragma("unroll") for (int tv = 0; tv < 2; ++tv) o[tv] = mfma32(*(const LAS bf16x8*)(vread + (stg_) + 32 * tv * AT_PITCH + 64 * (u_) + 32 * s2), pb, o[tv]); } \
        __builtin_amdgcn_s_setprio(0); } while (0)
    for (int it = 0; it < nt; ++it) {
        { LAS unsigned char* d = sdst + ((it + 1) % AT_NSTAGE) * AT_STAGE; *(LAS u32x4*)d = kreg; *(LAS u32x4*)(d + AT_KBYTES) = vreg; }
        { const int t2 = it + 2 < nt ? it + 2 : nt - 1; kreg = *(const u32x4*)(ksrc + (size_t)t2 * 64 * 512); vreg = *(const u32x4*)(vsrc + t2 * 64); }
        unsigned long long mw_next = mrow[it + 1 < nt ? it + 1 : nt - 1];
        if (2 * (it + 1) > qt) mw_next = 0ull;
        __syncthreads();
        const int stg = (it % AT_NSTAGE) * AT_STAGE;
        if (2 * it <= qt) { f32x16 s; AT_QK(s, stg, 0); AT_SMPV(s, mw, stg, 0); }
        if (2 * it + 1 <= qt) { f32x16 s; AT_QK(s, stg, 1); AT_SMPV(s, mw >> 32, stg, 1); }
        mw = mw_next;
    }
#undef AT_QK
#undef AT_SMPV
    l = x32_sum(l);
    const float inv = 1.0f / l;
    bf16* CAT = cat_base + qrow * D + 64 * h;
#pragma unroll
    for (int tv = 0; tv < 2; ++tv)
#pragma unroll
        for (int g = 0; g < 4; ++g)
            *(u32x2*)(CAT + 32 * tv + 8 * g + 4 * hi) = (u32x2){cvtpk(o[tv][4 * g] * inv, o[tv][4 * g + 1] * inv), cvtpk(o[tv][4 * g + 2] * inv, o[tv][4 * g + 3] * inv)};
    __syncthreads();
}
__device__ __forceinline__ void attn_dense_item3(Frame& F, int b, int h, int qb, bf16* cat_base) {
    const int tid = F.tid, lane = F.lane, w = F.wave, c = lane & 31, hi = lane >> 5;
    const int qt = 8 * qb + w;
    const size_t qrow = (size_t)b * SEQ + 32 * qt + c;
    bf16x8 Bq[4];
#pragma unroll
    for (int kk = 0; kk < 4; ++kk) Bq[kk] = ld8(WSP(bf16, WS_Q) + qrow * 512 + 64 * h + 16 * kk + 8 * hi);
    const unsigned long long* mrow = WSP(unsigned long long, WS_MASK) + qrow * 128;
    const int nt = 4 * qb + 4, nd = nt >> 1;
    const int sr = tid >> 3, spc = tid & 7;
    const bf16* ksrc = WSP(bf16, WS_K) + ((size_t)b * SEQ + sr) * 512 + 64 * h + 8 * spc;
    const bf16* vsrc = WSP(bf16, WS_VTA) + ((size_t)(b * 8 + h) * 64 + sr) * SEQ + 8 * spc;
    LAS unsigned char* sdst = F.lds + sr * AT_PITCH + 16 * spc;
    u32x4 kreg[2], vreg[2];
#pragma unroll
    for (int s = 0; s < 2; ++s) { kreg[s] = *(const u32x4*)(ksrc + (size_t)s * 64 * 512); vreg[s] = *(const u32x4*)(vsrc + s * 64); }
#pragma unroll
    for (int s = 0; s < 2; ++s) { *(LAS u32x4*)(sdst + s * AT_STAGE) = kreg[s]; *(LAS u32x4*)(sdst + s * AT_STAGE + AT_KBYTES) = vreg[s]; }
#pragma unroll
    for (int s = 0; s < 2; ++s) { const int t1 = 2 + s < nt ? 2 + s : nt - 1; kreg[s] = *(const u32x4*)(ksrc + (size_t)t1 * 64 * 512); vreg[s] = *(const u32x4*)(vsrc + t1 * 64); }
    unsigned long long mw[2] = {mrow[0], mrow[1]};
    f32x16 o[2];
#pragma unroll
    for (int tv = 0; tv < 2; ++tv)
#pragma unroll
        for (int i = 0; i < 16; ++i) o[tv][i] = 0.f;
    float l = 0.f;
    const LAS unsigned char* kread = F.lds + c * AT_PITCH + 16 * hi;
    const LAS unsigned char* vread = F.lds + AT_KBYTES + c * AT_PITCH + 16 * hi;
    for (int j = 0; j < nd; ++j) {
        { LAS unsigned char* d = sdst + ((j + 1) % 3) * 2 * AT_STAGE;
#pragma unroll
          for (int s = 0; s < 2; ++s) { *(LAS u32x4*)(d + s * AT_STAGE) = kreg[s]; *(LAS u32x4*)(d + s * AT_STAGE + AT_KBYTES) = vreg[s]; } }
#pragma unroll
        for (int s = 0; s < 2; ++s) { const int t2 = 2 * j + 4 + s < nt ? 2 * j + 4 + s : nt - 1; kreg[s] = *(const u32x4*)(ksrc + (size_t)t2 * 64 * 512); vreg[s] = *(const u32x4*)(vsrc + t2 * 64); }
        const unsigned long long mwn0 = mrow[2 * j + 2 < nt ? 2 * j + 2 : nt - 1], mwn1 = mrow[2 * j + 3 < nt ? 2 * j + 3 : nt - 1];
        __syncthreads();
#pragma unroll
        for (int s = 0; s < 2; ++s) {
            const int it = 2 * j + s, stg = ((j % 3) * 2 + s) * AT_STAGE;
#pragma unroll
            for (int u = 0; u < 2; ++u) {
                if (2 * it + u <= qt) {
                    f32x16 sd;
#pragma unroll
                    for (int i = 0; i < 16; ++i) sd[i] = 0.f;
                    __builtin_amdgcn_s_setprio(1);
#pragma unroll
                    for (int kk = 0; kk < 4; ++kk) sd = mfma32(*(const LAS bf16x8*)(kread + stg + 32 * u * AT_PITCH + 32 * kk), Bq[kk], sd);
                    __builtin_amdgcn_s_setprio(0);
                    const unsigned Wh = (unsigned)(mw[s] >> (32 * u)) >> (4 * hi); float ps = 0.f;
#pragma unroll
                    for (int r = 0; r < 16; ++r) { const float p = fast_exp2(sd[r]);
                        const float pm = __uint_as_float(__float_as_uint(p) & (unsigned)__builtin_amdgcn_sbfe((int)Wh, 8 * (r >> 2) + (r & 3), 1)); ps += pm; sd[r] = pm; }
                    l += ps; __builtin_amdgcn_s_setprio(1);
#pragma unroll
                    for (int s2 = 0; s2 < 2; ++s2) {
                        const u32x4 pw = {cvtpk(sd[8 * s2], sd[8 * s2 + 1]), cvtpk(sd[8 * s2 + 2], sd[8 * s2 + 3]), cvtpk(sd[8 * s2 + 4], sd[8 * s2 + 5]), cvtpk(sd[8 * s2 + 6], sd[8 * s2 + 7])};
                        const bf16x8 pb = __builtin_bit_cast(bf16x8, pw);
#pragma unroll
                        for (int tv = 0; tv < 2; ++tv) o[tv] = mfma32(*(const LAS bf16x8*)(vread + stg + 32 * tv * AT_PITCH + 64 * u + 32 * s2), pb, o[tv]);
                    }
                    __builtin_amdgcn_s_setprio(0);
                }
            }
        }
        mw[0] = mwn0; mw[1] = mwn1;
    }
    l = x32_sum(l);
    const float inv = 1.0f / l;
    bf16* CAT = cat_base + qrow * D + 64 * h;
#pragma unroll
    for (int tv = 0; tv < 2; ++tv)
#pragma unroll
        for (int g = 0; g < 4; ++g)
            *(u32x2*)(CAT + 32 * tv + 8 * g + 4 * hi) = (u32x2){cvtpk(o[tv][4 * g] * inv, o[tv][4 * g + 1] * inv), cvtpk(o[tv][4 * g + 2] * inv, o[tv][4 * g + 3] * inv)};
    __syncthreads();
}
template <bool MEM>
__device__ __forceinline__ void attend_sample_wg(Frame& F, int b, int h, LAS float* sm  ) {
    const int lane = F.lane, w = F.wave; const size_t row = MPR + b;
    LAS float* qs = sm; LAS float* sc = sm + 64; LAS float* part = sm + 320;
    const unsigned short* slist = WSP(unsigned short, WS_SLIST) + b * 256;
    if (w == 0) qs[lane] = MEM ? bf2f(WSP(bf16, WS_MQ)[row * 256 + 64 * h + lane]) : bf2f(WSP(bf16, WS_Q)[row * 512 + 64 * h + lane]);
    __syncthreads();
    if (opaque_s(w) < 4) {
        const int idx = MEM ? 64 * w + lane : (int)slist[64 * w + lane];
        const float* kp = MEM ? FP(7) + (((size_t)b * 256 + idx) * 4 + h) * 64
                              : (idx < PAST ? FP(3) + (((size_t)FPI(9)[b * NPAGES + (idx >> 7)] * PAGE + (idx & 127)) * 512 + 64 * h) : F.out + O_KS + (size_t)b * 512 + 64 * h);
        f32x4 kv[16];
#pragma unroll
        for (int d4 = 0; d4 < 16; ++d4) kv[d4] = *(const f32x4*)(kp + 4 * d4);
        float a = 0.f;
#pragma unroll
        for (int d4 = 0; d4 < 16; ++d4) { const f32x4 q = *(const LAS f32x4*)(qs + 4 * d4); a = fmaf(kv[d4][0], q[0], fmaf(kv[d4][1], q[1], fmaf(kv[d4][2], q[2], fmaf(kv[d4][3], q[3], a)))); }
        sc[64 * w + lane] = a * (MEM ? 0.125f : 1.0f / LOG2E);
    }
    __syncthreads();
    float s4[4];
#pragma unroll
    for (int m = 0; m < 4; ++m) s4[m] = sc[64 * m + lane];
    const float mx = wave_max(fmaxf(fmaxf(s4[0], s4[1]), fmaxf(s4[2], s4[3])));
    float sum = 0.f;
#pragma unroll
    for (int m = 0; m < 4; ++m) { s4[m] = fast_exp2((s4[m] - mx) * LOG2E); sum += s4[m]; }
    sum = wave_sum(sum);
    __syncthreads();
    if (w == 0) {
#pragma unroll
        for (int m = 0; m < 4; ++m) sc[64 * m + lane] = s4[m];
    }
    __syncthreads();
    float vv[32];
#pragma unroll
    for (int j = 0; j < 32; ++j) {
        const int idx = MEM ? 32 * w + j : __builtin_amdgcn_readfirstlane((int)slist[32 * w + j]);
        const float* vp = MEM ? FP(8) + (((size_t)b * 256 + idx) * 4 + h) * 64
                              : (idx < PAST ? FP(4) + (((size_t)FPI(9)[b * NPAGES + (idx >> 7)] * PAGE + (idx & 127)) * 512 + 64 * h) : F.out + O_VS + (size_t)b * 512 + 64 * h);
        vv[j] = vp[lane];
    }
    float o = 0.f;
#pragma unroll
    for (int j = 0; j < 32; ++j) o = fmaf(sc[32 * w + j], vv[j], o);
    part[64 * w + lane] = o;
    __syncthreads();
    if (w == 0) {
        float t = 0.f;
#pragma unroll
        for (int k = 0; k < 8; ++k) t += part[64 * k + lane];
        WSP(bf16, WS_CAT)[row * D + (MEM ? 768 : 0) + 64 * h + lane] = f2bf(t / sum);
    }
    __syncthreads();
}

#define N_LAUNCHES_IS_ONE (MK_N_LAUNCHES == 1)
struct Args { const void* in[26]; float* out; unsigned char* ws; int ph_lo, ph_hi; };
__device__ __forceinline__ bool SS_IN_P3(int G) { const int nr = (MIX_UNITS + G - 1) / G, first_idle = MIX_UNITS - (nr - 1) * G; return N_LAUNCHES_IS_ONE && (G - first_idle) * 4 >= G; }
constexpr int N_LAUNCHES = MK_N_LAUNCHES;

__global__ void __launch_bounds__(NWAVES * 64, 2) mk_fwd(Args args) {
    extern __shared__ __attribute__((aligned(16))) unsigned char lds[];
    Frame F;
    F.lds = (LAS unsigned char*)lds;
    F.wave = __builtin_amdgcn_readfirstlane(threadIdx.x >> 6); F.lane = hw_lane(); F.tid = (F.wave << 6) | F.lane;
    F.G = gridDim.x; F.gw = blockIdx.x * NWAVES + F.wave; F.ngw = F.G * NWAVES;
    F.ws = args.ws; F.out = args.out; F.ctl = (unsigned*)(args.ws + WS_CTL);
    F.in = args.in;

    for (int u = F.tid; u < (LDS_BYTES - LDSCTL_OFF) / 4; u += NWAVES * 64) ((LAS unsigned*)(F.lds + LDSCTL_OFF))[u] = 0u;
    __syncthreads();
    XcdBarrier bar; bar.bar = F.ctl + CW_BAR; bar.x = 0; bar.st = nullptr;
    if (N_LAUNCHES == 1) bar = xcd_barrier_post(F.ctl + CW_BAR, (volatile LAS unsigned*)(F.lds + MISC_OFF) + 8, F.tid == 0);
    const int lo = N_LAUNCHES == 1 ? 0 : args.ph_lo, hi = N_LAUNCHES == 1 ? N_PHASES : args.ph_hi;
#ifndef PH_MASK
#define PH_MASK 0x7ff
#endif
#define IN(k) (((PH_MASK >> (k)) & 1) && lo <= (k) && (k) < hi)
#define RELANE() do { F.lane = hw_lane(); F.tid = (F.wave << 6) | F.lane; } while (0)
#define SEAM(k) do { if (IN(k) && IN((k) + 1)) { xcd_barrier(bar, F.wave == 0 && hw_lane() == 0); RELANE(); } } while (0)
#ifndef REPEAT_MASK
#define REPEAT_MASK 0
#endif
#define NREP(k) ((((REPEAT_MASK) >> (k)) & 1) + 1)
#define REP(k) for (int rep = 0; rep < NREP(k); ++rep)
#define REPBAR(k) do { if (rep + 1 < NREP(k)) { xcd_barrier(bar, F.wave == 0 && hw_lane() == 0); RELANE(); } } while (0)
    LAS unsigned char* ring = F.lds;

    RELANE(); if (IN(0)) { REP(0) { p0_prologue(F); REPBAR(0); } SEAM(0); }

    RELANE(); if (IN(1)) {
        pg8::Gemm g{WSP(bf16, WS_XB), WSP(bf16, WS_WGU1), MP, NGU, D}; UpOrder S; S.init(F.G, (int)blockIdx.x, F.ctl + CW_UPFLAG1, (LAS unsigned*)(F.lds + MISC_OFF + 1024));
        EpiSwiGLU E{WSP(bf16, WS_ACT), WSP(float, WS_RS), 1.0f, nullptr};
        REP(1) { pg8::gemm_phase<EpiSwiGLU, UpOrder, true, true>(ring, g, S, E, F.tid); REPBAR(1); }
        if (skinny_early(F.G) && (int)blockIdx.x >= UP_UNITS % F.G) {
            if (F.tid == 0) { while (xb_ld(F.ctl + CW_UPFLAG1) < (unsigned)UP_FLAG_TARGET) __builtin_amdgcn_s_sleep(2); }
            __syncthreads();
            __builtin_amdgcn_fence(__ATOMIC_ACQUIRE, "agent");
            for (int grp = (int)blockIdx.x - UP_UNITS % F.G; grp < 16; grp += F.G - UP_UNITS % F.G)
                skinny_resid<FF>(F, WSP(bf16, WS_ACT) + (size_t)MPR * FF, WSP(bf16, WS_WD1), grp, WSP(bf16, WS_XB) + (size_t)MPR * D, nullptr, WSP(bf16, WS_XB) + (size_t)MPR * D, WSP(float, WS_RS) + (size_t)MPR * 16, 0.5f, (LAS float*)F.lds);
        }
        SEAM(1);
    }
    RELANE(); if (IN(2)) {
        if (!skinny_early(F.G)) for (int grp = blockIdx.x; grp < 16; grp += F.G)
            skinny_resid<FF>(F, WSP(bf16, WS_ACT) + (size_t)MPR * FF, WSP(bf16, WS_WD1), grp, WSP(bf16, WS_XB) + (size_t)MPR * D, nullptr, WSP(bf16, WS_XB) + (size_t)MPR * D, WSP(float, WS_RS) + (size_t)MPR * 16, 0.5f, (LAS float*)F.lds);
        pg8::Gemm g{WSP(bf16, WS_ACT), WSP(bf16, WS_WD1), MPR, D, FF}; pg8::StaticOrder S; S.init(MPR, D, F.G, (int)blockIdx.x);
        EpiResid E{WSP(bf16, WS_XB), WSP(bf16, WS_XB), WSP(float, WS_RS), nullptr, nullptr, 0.5f};
        REP(2) { pg8::gemm_phase<EpiResid, pg8::StaticOrder, true, true>(ring, g, S, E, F.tid); REPBAR(2); }
        SEAM(2);
    }
    RELANE(); if (IN(3)) {
        pg8::Gemm g{WSP(bf16, WS_XB), WSP(bf16, WS_WIN), XBROWS, NINX, D}; MixOrder S; S.init(F.G, (int)blockIdx.x, F.ctl + CW_SSFLAG, (LAS unsigned*)(F.lds + MISC_OFF + 1024));
        EpiMix E{WSP(float, WS_RS), FP(15), FP(16), FP(20), FP(21), WSP(float, WS_ROPE),
                 WSP(bf16, WS_Q), WSP(bf16, WS_K), WSP(bf16, WS_V), WSP(bf16, WS_QI), WSP(bf16, WS_KI), WSP(bf16, WS_RQ), WSP(bf16, WS_RK), WSP(bf16, WS_RV), WSP(bf16, WS_SG), WSP(bf16, WS_MQ),
                 WSP(bf16, WS_RKDT), WSP(bf16, WS_RVT), WSP(bf16, WS_MK), WSP(bf16, WS_MVT), WSP(float, WS_WI), F.out, WSP(bf16, WS_VTA)};
        REP(3) { pg8::gemm_phase<EpiMix, MixOrder, true, true>(ring, g, S, E, F.tid); REPBAR(3); }
        if (SS_IN_P3(F.G)) {
            const int nr = (MIX_UNITS + F.G - 1) / F.G, first_idle = MIX_UNITS - (nr - 1) * F.G;
            if ((int)blockIdx.x >= first_idle) {
                if (F.tid == 0) { while (xb_ld(F.ctl + CW_SSFLAG) < (unsigned)MIX_FLAG_TARGET) __builtin_amdgcn_s_sleep(2); }
                __syncthreads();
                __builtin_amdgcn_fence(__ATOMIC_ACQUIRE, "agent");
                const int nidw = (F.G - first_idle) * NWAVES;
                const int nitems = NSAMP * 65, whole = (nitems / nidw) * nidw, total = whole + 2 * (nitems - whole);
                const int widx = ((int)blockIdx.x - first_idle) * NWAVES + F.wave, per = whole / nidw; int prev_b = -1;
                for (int j = 0; j < per; ++j) {
                    const int it = widx * per + j, b = it / 65;
                    sample_scores_item(F, b, it % 65, (LAS float*)(F.lds + F.wave * 4096), 0, 2, b == prev_b); prev_b = b;
                }
                for (int ix = whole + widx; ix < total; ix += nidw) {
                    const int it = whole + ((ix - whole) >> 1), kq0 = (ix - whole) & 1, b = it / 65;
                    sample_scores_item(F, b, it % 65, (LAS float*)(F.lds + F.wave * 4096), kq0, kq0 + 1, b == prev_b); prev_b = b;
                }
            }
        }
        SEAM(3);
    }
    RELANE(); if (IN(4)) {
        LAS float* wl = (LAS float*)(F.lds + F.wave * 4096);
#ifndef P4_MASK
#define P4_MASK 63
#endif
        REP(4) {
#ifndef P4_REP_MASK
#define P4_REP_MASK 63
#endif
        const int p4m = rep == 0 ? P4_MASK : P4_REP_MASK;
        if ((p4m & 1) && !SS_IN_P3(F.G)) for (int it = F.gw; it < NSAMP * 65; it += F.ngw) sample_scores_item(F, it / 65, it % 65, wl);
        if (p4m & 8) for (int it = F.gw; it < 2048; it += F.ngw) ret_kv_item(F, it);
#ifndef IDX_STAGGER
#define IDX_STAGGER 3
#endif
#ifdef DBG_IDX_NOSTORE2
#define IDX_DO_STORE (rep == 0)
#else
#define IDX_DO_STORE true
#endif

        if (p4m & 32) for (int p = blockIdx.x; p < 256; p += F.G) {
            const int b = p >> 7, qa = p & 127, qz = 255 - qa, lo = (F.wave * 257) >> 3, hi = ((F.wave + 1) * 257) >> 3, na = qa + 1;
            if (lo < na) idx_scores_item(b, qa, lo, hi < na ? hi : na, WSP(bf16, WS_QI), WSP(bf16, WS_KI), WSP(float, WS_WI), WSP(unsigned, WS_SC), F.lane, F.lds + 32768 + F.wave * 4608);
            if (hi > na) idx_scores_item(b, qz, (lo > na ? lo : na) - na, hi - na, WSP(bf16, WS_QI), WSP(bf16, WS_KI), WSP(float, WS_WI), WSP(unsigned, WS_SC), F.lane, F.lds + 32768 + F.wave * 4608);
        }
        REPBAR(4); }
        SEAM(4);
    }
    RELANE(); if (IN(5)) {
        LAS unsigned char* wb = F.lds + F.wave * 14336;
        LAS unsigned* hist = (LAS unsigned*)wb; LAS unsigned short* list = (LAS unsigned short*)(wb + 1024);
        REP(5) {
#ifdef DBG_P5_SMALL2
        if (DBG_P5_SMALL2 & 1) p5_scan(F);
        if (DBG_P5_SMALL2 & 2) for (int it = blockIdx.x; it < 256; it += F.G) mem_attn_wg(F, it);
        if (DBG_P5_SMALL2 & 4) for (int it = (int)blockIdx.x - 128; it >= 0 && it < NSAMP * 4; it += F.G) attend_sample_wg<true>(F, it >> 2, it & 3, (LAS float*)(F.lds + 116736));
        if (DBG_P5_SMALL2 & 8) for (int it = F.ngw - 1 - F.gw; it < 128; it += F.ngw) sample_ret_item(F, it);
#endif
        p5_scan(F);
        for (int it = blockIdx.x; it < 256; it += F.G) mem_attn_wg(F, it);
        for (int it = (int)blockIdx.x - 128; it >= 0 && it < NSAMP * 4; it += F.G) attend_sample_wg<true>(F, it >> 2, it & 3, (LAS float*)(F.lds + 116736));
        for (int it = F.ngw - 1 - F.gw; it < 128; it += F.ngw) sample_ret_item(F, it);
        const bool selblk = (int)blockIdx.x >= 64 && (int)blockIdx.x < 64 + NSAMP;
        if (selblk && F.wave == 0) {
            const int b = (int)blockIdx.x - 64;
            (void)select_topk<17, false, float>(WSP(float, WS_SSC) + (size_t)b * SSC_LD, PAST + 1, hist, list, nullptr, F.lane);
            u32x2* dst = (u32x2*)(WSP(unsigned short, WS_SLIST) + b * 256);
            dst[F.lane] = *(const LAS u32x2*)(list + 4 * F.lane);
        }
        for (int base = F.gw; base < 2048; base += F.ngw) {
            auto qmap = [&](int qi, int& b, int& t) -> bool {
                int src = base, q = qi;
                if (qi >= 8) { if (!(selblk && (F.wave == 1 || F.wave == 2))) return false; src = base - F.wave; q = 5 + F.wave; }
                else if (selblk && F.wave == 0 && qi >= 6) return false;
                b = q >> 2; const int q4 = q & 3;
                t = q4 == 0 ? src : (q4 == 1 ? 4095 - src : (q4 == 2 ? 4096 + src : 8191 - src));
                return true;
            };
            for (int qi = 0; qi < 9; ++qi) {
                int b, t; if (!qmap(qi, b, t)) continue;
                int nb = 0, nt = 0; bool hasn = false;
                for (int q2 = qi + 1; q2 < 9 && !hasn; ++q2) hasn = qmap(q2, nb, nt);
#ifdef SEL_PREFETCH
                const unsigned* nrow = hasn ? WSP(unsigned, WS_SC) + ((size_t)nb * SEQ + nt) * SEQ : nullptr;
#else
                const unsigned* nrow = nullptr;
#endif
#ifdef DBG_SEL2
                (void)select_topk<16, true, unsigned>(WSP(unsigned, WS_SC) + ((size_t)b * SEQ + t) * SEQ, t + 1, hist, list, WSP(unsigned long long, WS_MASK) + ((size_t)b * SEQ + t) * 128, F.lane);
#endif
                (void)select_topk<16, true, unsigned>(WSP(unsigned, WS_SC) + ((size_t)b * SEQ + t) * SEQ, t + 1, hist, list, WSP(unsigned long long, WS_MASK) + ((size_t)b * SEQ + t) * 128, F.lane, nrow, hasn ? nt + 1 : 0);
            }
        }
        REPBAR(5); }
        SEAM(5);
    }
    RELANE(); if (IN(7)) {
        REP(7) {
#ifdef DBG_P7_ONCE
        if (rep == NREP(7) - 1)
#endif
        for (int it = opaque_s((int)blockIdx.x); it < NSAMP * 8; it += F.G) attend_sample_wg<false>(F, it >> 3, it & 7, (LAS float*)(F.lds + 116736));
        for (int it = opaque_s(F.gw); it < 2048; it += F.ngw) ret_out_item(F, it);
        __syncthreads();
        const float mfix = 8.0f * wave_max(fabsf(FP(15)[F.lane])) * wave_max(fabsf(FP(16)[F.lane]));
        const bool fixed_ok = mfix < 40.0f;
        for (int p = opaque_s((int)blockIdx.x); p < 256; p += F.G) {
            const int combo = (p & 7) + 8 * ((p >> 3) & 1), pr = p >> 4, b = combo >> 3, h = combo & 7;
            bf16* catb = (rep + 1 < NREP(7)) ? WSP(bf16, WS_SC) : WSP(bf16, WS_CAT);
#ifdef DBG_P7_TWICE
            if (fixed_ok) { attn_dense_item3(F, b, h, 31 - pr, catb); attn_dense_item3(F, b, h, pr, catb); }
#endif
            if (fixed_ok) { attn_dense_item3(F, b, h, 31 - pr, catb); attn_dense_item3(F, b, h, pr, catb); }
            else { attn_dense_item<false>(F, b, h, 31 - pr, catb, mfix); attn_dense_item<false>(F, b, h, pr, catb, mfix); }
        }
        REPBAR(7); }
        SEAM(7);
    }
    RELANE(); if (IN(8)) {
        for (int grp = blockIdx.x; grp < 16; grp += F.G)
            skinny_resid<D>(F, WSP(bf16, WS_CAT) + (size_t)MPR * D, WSP(bf16, WS_WOUT), grp, WSP(bf16, WS_XB) + (size_t)MPR * D, nullptr, WSP(bf16, WS_XB) + (size_t)MPR * D, WSP(float, WS_RS) + (size_t)MPR * 16, 1.0f, (LAS float*)F.lds, WSP(unsigned char, WS_X1) + (size_t)MPR * D);
        pg8::Gemm g{WSP(bf16, WS_CAT), WSP(bf16, WS_WOUT), MPR, D, D}; pg8::StaticOrder S; S.init(MPR, D, F.G, (int)blockIdx.x);
#ifdef DBG_NO_X8
        EpiResid E{WSP(bf16, WS_XB), WSP(bf16, WS_XB), WSP(float, WS_RS), nullptr, nullptr, 1.0f};
#else
        EpiResid E{WSP(bf16, WS_XB), WSP(bf16, WS_XB), WSP(float, WS_RS), nullptr, WSP(unsigned char, WS_X1), 1.0f};
#endif
        pg8::gemm_phase<EpiResid, pg8::StaticOrder, true, true>(ring, g, S, E, F.tid);
        SEAM(8);
    }
    RELANE(); if (IN(9)) {
#ifdef DBG_NO_F8
        pg8::Gemm g{WSP(bf16, WS_XB), WSP(bf16, WS_WGU2), MP, NGU, D}; pg8::StaticOrder S; S.init(MP, NGU, F.G, (int)blockIdx.x);
        EpiSwiGLU E{WSP(bf16, WS_ACT), WSP(float, WS_RS), 1.0f, nullptr};
        pg8::gemm_phase<EpiSwiGLU, pg8::StaticOrder, true, true, false>(ring, g, S, E, F.tid);
#else
        pg8::Gemm g{WSP(bf16, WS_X1), WSP(bf16, WS_WGU2), MP, NGU, D / 2}; UpOrder S; S.init(F.G, (int)blockIdx.x, F.ctl + CW_UPFLAG2, (LAS unsigned*)(F.lds + MISC_OFF + 1024));
#ifdef DBG_NO_F8D
        EpiSwiGLU E{WSP(bf16, WS_ACT), WSP(float, WS_RS), 1.0f / W8SCALE, nullptr};
#else
        EpiSwiGLU E{WSP(bf16, WS_ACT), WSP(float, WS_RS), 1.0f / W8SCALE, WSP(unsigned char, WS_ACT)};
#endif
#ifdef DBG_P9_TWICE
        pg8::gemm_phase<EpiSwiGLU, UpOrder, true, true, true>(ring, g, S, E, F.tid); xcd_barrier(bar, F.wave == 0 && hw_lane() == 0); RELANE();
#endif
        REP(9) { pg8::gemm_phase<EpiSwiGLU, UpOrder, true, true, true>(ring, g, S, E, F.tid); REPBAR(9); }
#ifndef DBG_NO_F8D
        RELANE();
        if (skinny_early(F.G) && (int)blockIdx.x >= UP_UNITS % F.G) {
            if (F.tid == 0) { while (xb_ld(F.ctl + CW_UPFLAG2) < (unsigned)UP_FLAG_TARGET) __builtin_amdgcn_s_sleep(2); }
            __syncthreads();
            __builtin_amdgcn_fence(__ATOMIC_ACQUIRE, "agent");
            for (int grp = (int)blockIdx.x - UP_UNITS % F.G; grp < 16; grp += F.G - UP_UNITS % F.G)
                skinny_resid<FF, true>(F, (const bf16*)(WSP(unsigned char, WS_ACT) + (size_t)MPR * FF), WSP(bf16, WS_WD2), grp, WSP(bf16, WS_XB) + (size_t)MPR * D, F.out + O_YS, nullptr, nullptr, 0.5f / (W8SCALE * A8SCALE), (LAS float*)F.lds);
        }
#endif
#endif
        SEAM(9);
    }
    RELANE(); if (IN(10)) {
#ifdef DBG_NO_F8D
        for (int grp = blockIdx.x; grp < 16; grp += F.G)
            skinny_resid<FF>(F, WSP(bf16, WS_ACT) + (size_t)MPR * FF, WSP(bf16, WS_WD2), grp, WSP(bf16, WS_XB) + (size_t)MPR * D, F.out + O_YS, nullptr, nullptr, 0.5f, (LAS float*)F.lds);
        pg8::Gemm g{WSP(bf16, WS_ACT), WSP(bf16, WS_WD2), MPR, D, FF}; pg8::StaticOrder S; S.init(MPR, D, F.G, (int)blockIdx.x);
        EpiResid E{WSP(bf16, WS_XB), nullptr, nullptr, F.out + O_YP, nullptr, 0.5f};
        REP(10) { pg8::gemm_phase<EpiResid, pg8::StaticOrder, true, true>(ring, g, S, E, F.tid); REPBAR(10); }
#else
        if (!skinny_early(F.G)) for (int grp = blockIdx.x; grp < 16; grp += F.G)
            skinny_resid<FF, true>(F, (const bf16*)(WSP(unsigned char, WS_ACT) + (size_t)MPR * FF), WSP(bf16, WS_WD2), grp, WSP(bf16, WS_XB) + (size_t)MPR * D, F.out + O_YS, nullptr, nullptr, 0.5f / (W8SCALE * A8SCALE), (LAS float*)F.lds);
        pg8::Gemm g{WSP(bf16, WS_ACT), WSP(bf16, WS_WD2), MPR, D, FF / 2}; pg8::StaticOrder S; S.init(MPR, D, F.G, (int)blockIdx.x);
        EpiResid E{WSP(bf16, WS_XB), nullptr, nullptr, F.out + O_YP, nullptr, 0.5f / (W8SCALE * A8SCALE)};
        REP(10) { pg8::gemm_phase<EpiResid, pg8::StaticOrder, true, true, true>(ring, g, S, E, F.tid); REPBAR(10); }
#endif
    }
#undef IN
#undef SEAM
}

extern "C" void kernel_launch(void* const* d_in, const int* in_sizes, int n_in, void* d_out, int out_size, void* d_ws, size_t ws_size, hipStream_t stream) {
    static int grid = 0;
    if (grid == 0) {
        if (n_in != 26 || (size_t)out_size != O_END || ws_size < WS_END) { fprintf(stderr, "kernel_launch: unexpected shapes: n_in %d out %d (want %zu) ws %zu (want >= %zu); nothing launched\n", n_in, out_size, (size_t)O_END, ws_size, (size_t)WS_END); grid = -1; return; }
        int dev = 0, cus = 0, per_cu = 0;
        if (hipGetDevice(&dev) != hipSuccess || hipDeviceGetAttribute(&cus, hipDeviceAttributeMultiprocessorCount, dev) != hipSuccess) { fprintf(stderr, "kernel_launch: device query failed\n"); grid = -1; return; }
        if (hipFuncSetAttribute((const void*)mk_fwd, hipFuncAttributeMaxDynamicSharedMemorySize, LDS_BYTES) != hipSuccess) { fprintf(stderr, "kernel_launch: hipFuncSetAttribute failed\n"); grid = -1; return; }
        if (hipOccupancyMaxActiveBlocksPerMultiprocessor(&per_cu, (const void*)mk_fwd, NWAVES * 64, LDS_BYTES) != hipSuccess || per_cu < 1) { fprintf(stderr, "kernel_launch: occupancy query reports %d blocks per CU\n", per_cu); }
        (void)hipGetLastError();
        grid = cus;
    }
    if (grid < 0) return;
    if (hipMemsetAsync((char*)d_ws + WS_CTL, 0, CTL_ZERO_BYTES, stream) != hipSuccess) { fprintf(stderr, "kernel_launch: memset failed\n"); return; }
    Args a{};
    for (int i = 0; i < 26; ++i) a.in[i] = d_in[i];
    a.out = (float*)d_out; a.ws = (unsigned char*)d_ws;
    for (int li = 0; li < N_LAUNCHES; ++li) {
        a.ph_lo = (N_LAUNCHES == 1) ? 0 : li; a.ph_hi = (N_LAUNCHES == 1) ? N_PHASES : li + 1;
        hipLaunchKernelGGL(mk_fwd, dim3(grid), dim3(NWAVES * 64), LDS_BYTES, stream, a);
        const hipError_t le = hipPeekAtLastError();
        if (le != hipSuccess) { fprintf(stderr, "kernel_launch: launch %d failed: %s\n", li, hipGetErrorName(le)); break; }
    }
}
```
